# Optimizing an MI355X kernel written in HIP

```python
import math
import jax, jax.numpy as jnp
from jax import lax
import numpy as np

D_MODEL = 1024
BATCH = 1
SEQ = 16384
DEPTH = 4

CTX_LEN = 256
GRID_W = 64
EPS = 1e-6

A_HD = 64
A_HEADS = D_MODEL // 2 // A_HD * 2 // 2
A_W = A_HEADS * A_HD
A_LORA_W = 64
A_LORA_A = 64
A_SHIFT_COLS = 3 * A_W + 2 * A_LORA_W + 2 * A_LORA_A
A_GN_EPS = 64e-5
B_HD = 64
B_HEADS = D_MODEL // B_HD
B_W = B_HEADS * B_HD
B_GROUPS = 2
B_STATE = 128
B_XBC = B_W + 2 * B_GROUPS * B_STATE
CONV_K = 5
SSD_CHUNK = 128
C_HEADS = 4
C_HD = D_MODEL // C_HEADS
C_W = C_HEADS * C_HD
MLSTM_CHUNK = 128
D_HD = 64
D_HEADS = D_MODEL // D_HD
D_KV_HEADS = D_HEADS // 4
D_W = D_HEADS * D_HD
D_KV_W = D_KV_HEADS * D_HD
Q_BLOCK = 128
ROPE_THETA = 10000.0

AB_COLS = A_SHIFT_COLS + A_W + B_XBC + 2 * B_HEADS + B_W
AB_WIDTH = A_W + B_W
CD_COLS = 5 * C_W + 4 * C_HEADS + 2 * D_W + 2 * D_KV_W
CD_WIDTH = C_W + D_W
N_EVEN = (DEPTH + 1) // 2
N_ODD = DEPTH // 2

kernel_name = 'hybrid_rwkv7_ssd_mlstm_gqa_prefix'

F32 = jnp.float32


def rmsnorm(x, g):
    xf = x.astype(F32)
    y = xf * lax.rsqrt(jnp.mean(xf * xf, -1, keepdims=True) + EPS)
    return (y * g.astype(F32)).astype(x.dtype)


def split_cols(u, sizes):
    return jnp.split(u, np.cumsum(sizes)[:-1].tolist(), axis=-1)


def centred_shift(u):
    up = jnp.pad(u, ((0, 0), (1, 1), (0, 0)))
    return 0.5 * (up[:, :-2] + up[:, 2:])


def dwconv_centred(u, w, b):
    K, C = w.shape
    out = lax.conv_general_dilated(u, w[:, None, :].astype(u.dtype), window_strides=(1,),
                                   padding=[(K // 2, K // 2)], dimension_numbers=('NWC', 'WIO', 'NWC'),
                                   feature_group_count=C)
    return out + b.astype(u.dtype)


def rwkv7_bidir_scan(r, k_dir, v, decay, a, kk, S0):
    def dir_stack(u):
        return jnp.stack([u, jnp.flip(u, 1)], 0).transpose(2, 0, 1, 3, 4)

    def dir_split(u):
        u = jnp.moveaxis(u, 2, 0)
        return jnp.stack([u[0], jnp.flip(u[1], 1)], 0).transpose(2, 0, 1, 3, 4)

    def step(S, inp):
        r_t, k_t, v_t, w_t, a_t, kk_t = inp
        Skk = jnp.einsum('dbhvk,dbhk->dbhv', S, kk_t)
        S = S * w_t[..., None, :] - Skk[..., :, None] * (kk_t * a_t)[..., None, :] + v_t[..., :, None] * k_t[..., None, :]
        return S, jnp.einsum('dbhvk,dbhk->dbhv', S, r_t)

    xs = (dir_stack(r), dir_split(k_dir), dir_stack(v), dir_split(decay), dir_split(a), dir_stack(kk))
    S_fin, y = lax.scan(step, S0, xs)
    y = y[:, 0] + jnp.flip(y[:, 1], 0)
    return jnp.moveaxis(y, 0, 1), S_fin


def rwkv_branch(u_shift, u_gate, S0, p):
    Bsz, T = u_shift.shape[:2]
    u = (u_shift + p['mu'] * (centred_shift(u_shift) - u_shift)).astype(F32)
    r, k, v, wl, al = split_cols(u, [A_W, A_W, A_W, 2 * A_LORA_W, 2 * A_LORA_A])
    wl = wl.reshape(Bsz, T, 2, A_LORA_W)
    al = al.reshape(Bsz, T, 2, A_LORA_A)
    w_pre = p['w0'] + jnp.einsum('btdr,drc->btdc', jnp.tanh(wl), p['w2'])
    decay = jnp.exp(-jnp.exp(-jax.nn.softplus(-w_pre) - 0.5))
    a = jax.nn.sigmoid(p['a0'] + jnp.einsum('btdr,drc->btdc', al, p['a2']))

    def hs(t):
        return t.reshape(t.shape[:-1] + (A_HEADS, A_HD))

    kk = hs(k * p['k_k'])
    kk = kk / jnp.maximum(jnp.sqrt(jnp.sum(kk * kk, -1, keepdims=True)), 1e-12)
    k_dir = k[:, :, None] * (1.0 + (a - 1.0) * p['k_a'])
    y, S_fin = rwkv7_bidir_scan(hs(r), hs(k_dir), hs(v), hs(decay), hs(a), kk, S0)
    mu_ = jnp.mean(y, -1, keepdims=True)
    var = jnp.mean((y - mu_) ** 2, -1, keepdims=True)
    y = (y - mu_) * lax.rsqrt(var + A_GN_EPS) * hs(p['ln_w']) + hs(p['ln_b'])
    bonus = jnp.sum(hs(r) * hs(jnp.sum(k_dir, 2)) * p['r_k'], -1, keepdims=True)
    y = (y + bonus * hs(v)).reshape(Bsz, T, A_W)
    return y.astype(u_gate.dtype) * jax.nn.silu(u_gate), S_fin


def ssd_chunked(x, dt, A, Bm, Cm, S0):
    Bsz, T, H, P = x.shape
    G, N = Bm.shape[2:]
    E = H // G
    L = SSD_CHUNK
    nc = T // L
    x = x.reshape(Bsz, nc, L, G, E, P)
    dt = dt.reshape(Bsz, nc, L, G, E)
    Bm = Bm.reshape(Bsz, nc, L, G, N)
    Cm = Cm.reshape(Bsz, nc, L, G, N)
    Acs = jnp.cumsum(dt * A.reshape(G, E), axis=2)
    mask = jnp.tril(jnp.ones((L, L), bool))[:, :, None, None]
    seg = jnp.where(mask, Acs[:, :, :, None] - Acs[:, :, None, :], -jnp.inf)
    CB = jnp.einsum('bclgn,bcsgn->bclsg', Cm, Bm)
    Wm = CB[..., None] * jnp.exp(seg) * dt[:, :, None]
    y_diag = jnp.einsum('bclsge,bcsgep->bclgep', Wm, x)
    to_end = jnp.exp(Acs[:, :, -1:] - Acs) * dt
    states = jnp.einsum('bclgn,bclge,bclgep->bcgepn', Bm, to_end, x)
    chunk_decay = jnp.exp(Acs[:, :, -1])

    def pass_state(S, inp):
        st, dec = inp
        return S * dec[..., None, None] + st, S

    S_fin, S_in = lax.scan(pass_state, S0.reshape(Bsz, G, E, P, N),
                           (jnp.moveaxis(states, 1, 0), jnp.moveaxis(chunk_decay, 1, 0)))
    S_in = jnp.moveaxis(S_in, 0, 1)
    y_off = jnp.einsum('bclgn,bcgepn,bclge->bclgep', Cm, S_in, jnp.exp(Acs))
    return (y_diag + y_off).reshape(Bsz, T, H, P), S_fin.reshape(Bsz, H, P, N)


def ssd_bidir(x, dt, A, Bm, Cm, S0):
    def both(t):
        return jnp.stack([t, jnp.flip(t, 1)])
    dt2 = jnp.stack([dt[:, :, 0], jnp.flip(dt[:, :, 1], 1)])
    y2, S_fin = jax.vmap(ssd_chunked)(both(x), dt2, A, both(Bm), both(Cm), S0)
    return y2[0] + jnp.flip(y2[1], 1), S_fin


def mamba_branch(u_xbc, u_dt, u_z, S0, p):
    Bsz, T = u_xbc.shape[:2]
    xbc = jax.nn.silu(dwconv_centred(u_xbc, p['conv_w'], p['conv_b'])).astype(F32)
    xs, Bm, Cm = split_cols(xbc, [B_W, B_GROUPS * B_STATE, B_GROUPS * B_STATE])
    xs = xs.reshape(Bsz, T, B_HEADS, B_HD)
    Bm = Bm.reshape(Bsz, T, B_GROUPS, B_STATE)
    Cm = Cm.reshape(Bsz, T, B_GROUPS, B_STATE)
    dt = jax.nn.softplus(u_dt.astype(F32).reshape(Bsz, T, 2, B_HEADS) + p['dt_bias'])
    A = -jnp.exp(p['a_log'].astype(F32))
    y, S_fin = ssd_bidir(xs, dt, A, Bm, Cm, S0)
    y = y + p['d'][:, None] * xs
    y = y.reshape(Bsz, T, B_W) * jax.nn.silu(u_z.astype(F32))
    yg = y.reshape(Bsz, T, B_GROUPS, B_W // B_GROUPS)
    y = (yg * lax.rsqrt(jnp.mean(yg * yg, -1, keepdims=True) + EPS)).reshape(Bsz, T, B_W) * p['norm_w']
    return y.astype(u_z.dtype), S_fin


def mlstm_chunkwise(q, k, v, ig, lf, state0):
    Bsz, T, H, dh = q.shape
    L = MLSTM_CHUNK
    nc = T // L

    def to_chunks(t):
        return t.reshape(Bsz, nc, L, H, dh).transpose(1, 0, 3, 2, 4)

    def gate_chunks(t):
        return t.reshape(Bsz, nc, L, H).transpose(1, 0, 3, 2)

    causal = jnp.tril(jnp.ones((L, L), bool))

    def chunk_step(carry, inp):
        C_prev, n_prev, m_prev = carry
        qc, kc, vc, ic, fc = inp
        b = jnp.cumsum(fc, -1)
        logw = jnp.where(causal, b[..., :, None] - b[..., None, :] + ic[..., None, :], -jnp.inf)
        g = b + m_prev[..., None]
        m = jnp.maximum(g, jnp.max(logw, -1))
        s = jnp.einsum('bhld,bhsd->bhls', qc, kc) * jnp.exp(logw - m[..., None])
        wg = jnp.exp(g - m)
        num = jnp.einsum('bhls,bhsd->bhld', s, vc) + wg[..., None] * jnp.einsum('bhvd,bhld->bhlv', C_prev, qc)
        den = jnp.sum(s, -1) + wg * jnp.einsum('bhd,bhld->bhl', n_prev, qc)
        h = num / jnp.maximum(jnp.abs(den), jnp.exp(-m))[..., None]
        b_last = b[..., -1]
        logw_end = b_last[..., None] - b + ic
        m_new = jnp.maximum(b_last + m_prev, jnp.max(logw_end, -1))
        w_end = jnp.exp(logw_end - m_new[..., None])
        keep = jnp.exp(b_last + m_prev - m_new)
        C_new = keep[..., None, None] * C_prev + jnp.einsum('bhl,bhlv,bhld->bhvd', w_end, vc, kc)
        n_new = keep[..., None] * n_prev + jnp.einsum('bhl,bhld->bhd', w_end, kc)
        return (C_new, n_new, m_new), h

    state, h = lax.scan(chunk_step, state0, (to_chunks(q * dh ** -0.5), to_chunks(k), to_chunks(v),
                                             gate_chunks(ig), gate_chunks(lf)))
    return h.transpose(1, 0, 3, 2, 4).reshape(Bsz, T, H, dh), state


def mlstm_bidir(q, k, v, ig, lf, state0):
    def both(t):
        return jnp.stack([t, jnp.flip(t, 1)])
    ig2 = jnp.stack([ig[:, :, 0], jnp.flip(ig[:, :, 1], 1)])
    lf2 = jnp.stack([lf[:, :, 0], jnp.flip(lf[:, :, 1], 1)])
    h2, state = jax.vmap(mlstm_chunkwise)(both(q), both(k), both(v), ig2, lf2, state0)
    return h2[0] + jnp.flip(h2[1], 1), state


def mlstm_branch(u_qk, u_v, u_o, u_i, u_f, u_z, state0, p):
    Bsz, T = u_qk.shape[:2]
    qk = jax.nn.silu(dwconv_centred(u_qk, p['conv_w'], p['conv_b'])).astype(F32)
    q, k = split_cols(qk, [C_W, C_W])

    def hs(t):
        return t.reshape(Bsz, T, C_HEADS, C_HD)

    ig = u_i.astype(F32).reshape(Bsz, T, 2, C_HEADS) + p['i_bias']
    lf = jax.nn.log_sigmoid(u_f.astype(F32).reshape(Bsz, T, 2, C_HEADS) + p['f_bias'])
    h, state = mlstm_bidir(hs(q), hs(k), hs(u_v.astype(F32)), ig, lf, state0)
    h = h * lax.rsqrt(jnp.mean(h * h, -1, keepdims=True) + EPS) * p['norm_w'].reshape(C_HEADS, C_HD)
    h = h.reshape(Bsz, T, C_W) * jax.nn.sigmoid(u_o.astype(F32)) * jax.nn.silu(u_z.astype(F32))
    return h.astype(u_z.dtype), state


def rope_2d(x, row, col):
    half = x.shape[-1] // 2
    quarter = half // 2
    inv = ROPE_THETA ** (-jnp.arange(quarter, dtype=F32) / quarter)

    def rot(xa, pos):
        ang = pos.astype(F32)[:, None] * inv
        cos = jnp.cos(ang)[None, :, None, :]
        sin = jnp.sin(ang)[None, :, None, :]
        x1, x2 = xa[..., :quarter], xa[..., quarter:]
        return jnp.concatenate([x1 * cos - x2 * sin, x1 * sin + x2 * cos], -1)

    xf = x.astype(F32)
    return jnp.concatenate([rot(xf[..., :half], row), rot(xf[..., half:], col)], -1).astype(x.dtype)


def softmax_attend(q, k, v):
    s = jnp.einsum('bkgqd,bksd->bkgqs', q, k).astype(F32) * (q.shape[-1] ** -0.5)
    pr = jax.nn.softmax(s, axis=-1).astype(v.dtype)
    return jnp.einsum('bkgqs,bksd->bkgqd', pr, v)


def attn_branch(uq_l, uk_l, uv_l, ug_l, uq_c, uk_c, uv_c, ug_c, row, col, p, need_ctx):
    Bsz, T = uq_l.shape[:2]
    Cn = uq_c.shape[1]
    G = D_HEADS // D_KV_HEADS

    def qkv(uq, uk, uv):
        n = uq.shape[1]
        q = rmsnorm(uq.reshape(Bsz, n, D_HEADS, D_HD), p['q_norm'])
        k = rmsnorm(uk.reshape(Bsz, n, D_KV_HEADS, D_HD), p['k_norm'])
        return q, k, uv.reshape(Bsz, n, D_KV_HEADS, D_HD)

    q_l, k_l, v_l = qkv(uq_l, uk_l, uv_l)
    q_c, k_c, v_c = qkv(uq_c, uk_c, uv_c)
    q_l = rope_2d(q_l, row, col)
    k_l = rope_2d(k_l, row, col)

    def heads_first(t):
        return t.transpose(0, 2, 1, 3)

    K = heads_first(jnp.concatenate([k_l, k_c], 1))
    V = heads_first(jnp.concatenate([v_l, v_c], 1))
    qb = q_l.reshape(Bsz, T // Q_BLOCK, Q_BLOCK, D_KV_HEADS, G, D_HD).transpose(1, 0, 3, 4, 2, 5)
    o = lax.map(lambda blk: softmax_attend(blk, K, V), qb)
    y = o.transpose(1, 0, 4, 2, 3, 5).reshape(Bsz, T, D_W) * jax.nn.silu(ug_l)
    yc = None
    if need_ctx:
        qc = q_c.reshape(Bsz, Cn, D_KV_HEADS, G, D_HD).transpose(0, 2, 3, 1, 4)
        oc = softmax_attend(qc, heads_first(k_c), heads_first(v_c))
        yc = oc.transpose(0, 3, 1, 2, 4).reshape(Bsz, Cn, D_W) * jax.nn.silu(ug_c)
    return y, yc


def mixer_ab(u, uc, prk, pmb, need_ctx):
    sizes = [A_SHIFT_COLS, A_W, B_XBC, 2 * B_HEADS, B_W]
    rk_l, ga_l, xbc_l, dt_l, z_l = split_cols(u, sizes)
    rk_c, ga_c, xbc_c, dt_c, z_c = split_cols(uc, sizes)
    Bsz = u.shape[0]
    s_rk = jnp.zeros((2, Bsz, A_HEADS, A_HD, A_HD), F32)
    ya_c, s_rk = rwkv_branch(rk_c, ga_c, s_rk, prk)
    ya_l, _ = rwkv_branch(rk_l, ga_l, s_rk, prk)
    s_mb = jnp.zeros((2, Bsz, B_HEADS, B_HD, B_STATE), F32)
    yb_c, s_mb = mamba_branch(xbc_c, dt_c, z_c, s_mb, pmb)
    yb_l, _ = mamba_branch(xbc_l, dt_l, z_l, s_mb, pmb)
    y = jnp.concatenate([ya_l, yb_l], -1)
    yc = jnp.concatenate([ya_c, yb_c], -1) if need_ctx else None
    return y, yc


def mixer_cd(u, uc, pml, pat, row, col, need_ctx):
    sizes = [2 * C_W, C_W, C_W, 2 * C_HEADS, 2 * C_HEADS, C_W, D_W, D_KV_W, D_KV_W, D_W]
    qk_l, v_l, o_l, i_l, f_l, z_l, aq_l, ak_l, av_l, ag_l = split_cols(u, sizes)
    qk_c, v_c, o_c, i_c, f_c, z_c, aq_c, ak_c, av_c, ag_c = split_cols(uc, sizes)
    Bsz = u.shape[0]
    st = (jnp.zeros((2, Bsz, C_HEADS, C_HD, C_HD), F32), jnp.zeros((2, Bsz, C_HEADS, C_HD), F32),
          jnp.zeros((2, Bsz, C_HEADS), F32))
    yc_c, st = mlstm_branch(qk_c, v_c, o_c, i_c, f_c, z_c, st, pml)
    yc_l, _ = mlstm_branch(qk_l, v_l, o_l, i_l, f_l, z_l, st, pml)
    yd_l, yd_c = attn_branch(aq_l, ak_l, av_l, ag_l, aq_c, ak_c, av_c, ag_c, row, col, pat, need_ctx)
    y = jnp.concatenate([yc_l, yd_l], -1)
    yc = jnp.concatenate([yc_c, yd_c], -1) if need_ctx else None
    return y, yc


def setup_inputs(seed: int = 0) -> dict:
    key = jax.random.key(seed)
    ks = iter(jax.random.split(key, 48))
    D = D_MODEL

    def nrm(shape, s=1.0):
        return s * jax.random.normal(next(ks), shape, F32)

    dt0 = jnp.exp(jax.random.uniform(next(ks), (N_EVEN, 2, B_HEADS), F32, math.log(1e-3), math.log(1e-1)))
    return {
        'x': nrm((BATCH, SEQ, D)),
        'c': nrm((BATCH, D)),
        'ctx': nrm((BATCH, CTX_LEN, D)),
        'c_ctx': nrm((D,)),
        'norm_g': 1.0 + nrm((DEPTH, D), 0.05),
        'ada_w': nrm((DEPTH, D, 3 * D), 0.5 * D ** -0.5),
        'ada_b': nrm((DEPTH, 3 * D), 0.02),
        'norm_final': 1.0 + nrm((D,), 0.05),
        'ab_w_in': nrm((N_EVEN, D, AB_COLS), D ** -0.5),
        'ab_w_out': nrm((N_EVEN, AB_WIDTH, D), AB_WIDTH ** -0.5),
        'rk_mu': jax.random.uniform(next(ks), (N_EVEN, A_SHIFT_COLS), F32),
        'rk_w0': jnp.linspace(-6.0, -1.0, A_W, dtype=F32) + nrm((N_EVEN, 2, A_W), 0.1),
        'rk_w2': nrm((N_EVEN, 2, A_LORA_W, A_W), 0.1 * A_LORA_W ** -0.5),
        'rk_a0': nrm((N_EVEN, 2, A_W), 0.1),
        'rk_a2': nrm((N_EVEN, 2, A_LORA_A, A_W), 0.1 * A_LORA_A ** -0.5),
        'rk_k_k': 0.85 + nrm((N_EVEN, A_W), 0.05),
        'rk_k_a': 1.0 + nrm((N_EVEN, A_W), 0.05),
        'rk_r_k': nrm((N_EVEN, A_HEADS, A_HD), 0.1),
        'rk_ln_w': 1.0 + nrm((N_EVEN, A_W), 0.05),
        'rk_ln_b': nrm((N_EVEN, A_W), 0.02),
        'mb_conv_w': nrm((N_EVEN, CONV_K, B_XBC), CONV_K ** -0.5),
        'mb_conv_b': nrm((N_EVEN, B_XBC), 0.02),
        'mb_dt_bias': dt0 + jnp.log(-jnp.expm1(-dt0)),
        'mb_a_log': jnp.log(jax.random.uniform(next(ks), (N_EVEN, 2, B_HEADS), F32, 1.0, 16.0)),
        'mb_d': 1.0 + nrm((N_EVEN, B_HEADS), 0.05),
        'mb_norm_w': 1.0 + nrm((N_EVEN, B_W), 0.05),
        'cd_w_in': nrm((N_ODD, D, CD_COLS), D ** -0.5),
        'cd_w_out': nrm((N_ODD, CD_WIDTH, D), CD_WIDTH ** -0.5),
        'ml_conv_w': nrm((N_ODD, CONV_K, 2 * C_W), CONV_K ** -0.5),
        'ml_conv_b': nrm((N_ODD, 2 * C_W), 0.02),
        'ml_i_bias': nrm((N_ODD, 2, C_HEADS), 0.1),
        'ml_f_bias': jnp.linspace(3.0, 6.0, C_HEADS, dtype=F32) + nrm((N_ODD, 2, C_HEADS), 0.1),
        'ml_norm_w': 1.0 + nrm((N_ODD, C_W), 0.05),
        'at_q_norm': 1.0 + nrm((N_ODD, D_HD), 0.05),
        'at_k_norm': 1.0 + nrm((N_ODD, D_HD), 0.05),
    }


def reference(x, c, ctx, c_ctx, norm_g, ada_w, ada_b, norm_final, ab_w_in, ab_w_out, rk_mu, rk_w0, rk_w2,
              rk_a0, rk_a2, rk_k_k, rk_k_a, rk_r_k, rk_ln_w, rk_ln_b, mb_conv_w, mb_conv_b, mb_dt_bias,
              mb_a_log, mb_d, mb_norm_w, cd_w_in, cd_w_out, ml_conv_w, ml_conv_b, ml_i_bias, ml_f_bias,
              ml_norm_w, at_q_norm, at_k_norm):
    T = x.shape[1]
    rows = T // GRID_W
    row = jnp.repeat(jnp.arange(rows), GRID_W)
    col = jnp.arange(rows * GRID_W) % GRID_W
    cond = jax.nn.silu(c)
    cond_ctx = jax.nn.silu(c_ctx)
    for l in range(DEPTH):
        need_ctx = l < DEPTH - 1
        shift, scale, gate = jnp.split(cond @ ada_w[l] + ada_b[l], 3, -1)
        shift_c, scale_c, gate_c = jnp.split(cond_ctx @ ada_w[l] + ada_b[l], 3, -1)
        h = rmsnorm(x, norm_g[l]) * (1.0 + scale[:, None]) + shift[:, None]
        hc = rmsnorm(ctx, norm_g[l]) * (1.0 + scale_c) + shift_c
        j = l // 2
        if l % 2 == 0:
            prk = {'mu': rk_mu[j], 'w0': rk_w0[j], 'w2': rk_w2[j], 'a0': rk_a0[j], 'a2': rk_a2[j],
                   'k_k': rk_k_k[j], 'k_a': rk_k_a[j], 'r_k': rk_r_k[j], 'ln_w': rk_ln_w[j], 'ln_b': rk_ln_b[j]}
            pmb = {'conv_w': mb_conv_w[j], 'conv_b': mb_conv_b[j], 'dt_bias': mb_dt_bias[j],
                   'a_log': mb_a_log[j], 'd': mb_d[j], 'norm_w': mb_norm_w[j]}
            y, yc = mixer_ab(h @ ab_w_in[j], hc @ ab_w_in[j], prk, pmb, need_ctx)
            w_out = ab_w_out[j]
        else:
            pml = {'conv_w': ml_conv_w[j], 'conv_b': ml_conv_b[j], 'i_bias': ml_i_bias[j],
                   'f_bias': ml_f_bias[j], 'norm_w': ml_norm_w[j]}
            pat = {'q_norm': at_q_norm[j], 'k_norm': at_k_norm[j]}
            y, yc = mixer_cd(h @ cd_w_in[j], hc @ cd_w_in[j], pml, pat, row, col, need_ctx)
            w_out = cd_w_out[j]
        x = x + gate[:, None] * (y @ w_out)
        if need_ctx:
            ctx = ctx + gate_c * (yc @ w_out)
    return rmsnorm(x, norm_final)
```

```cpp
#include <hip/hip_runtime.h>
#include <hip/hip_cooperative_groups.h>
#include <cstdio>
#include <cstdint>
namespace cg = cooperative_groups;

#define TL 16384
#define TC 256
#define MT 16640
typedef unsigned short bf16_t;
typedef short bf16x8 __attribute__((ext_vector_type(8)));
typedef float f32x4 __attribute__((ext_vector_type(4)));
typedef unsigned u32x4 __attribute__((ext_vector_type(4)));
typedef unsigned u32x2 __attribute__((ext_vector_type(2)));

#define E_ELEMS ((size_t)MT * 1024)
#define OFF_CTXS 0u
#define OFF_MODS 1048576u
#define OFF_BONUS 1146880u
#define OFF_FSIDE 3276800u
#define OFF_WO 5406720u
#define OFF_R 9601024u
#define OFF_U 77758464u
#define LDS_BYTES 73728
#define OFF_BAR 260046848u

struct P {
  const float *x, *c, *ctx, *c_ctx, *norm_g, *ada_w, *ada_b, *norm_final, *ab_w_in, *ab_w_out;
  const float *rk_mu, *rk_w0, *rk_w2, *rk_a0, *rk_a2, *rk_k_k, *rk_k_a, *rk_r_k, *rk_ln_w, *rk_ln_b;
  const float *mb_conv_w, *mb_conv_b, *mb_dt_bias, *mb_a_log, *mb_d, *mb_norm_w, *cd_w_in, *cd_w_out;
  const float *ml_conv_w, *ml_conv_b, *ml_i_bias, *ml_f_bias, *ml_norm_w, *at_q_norm, *at_k_norm;
  float* out;
  unsigned char* ws;
};


__device__ __forceinline__ const P& params() {
  auto kp = __builtin_amdgcn_kernarg_segment_ptr();
  asm volatile("" : "+s"(kp));
  return *(const P*)kp;
}

__device__ __forceinline__ int ltid() { int t = threadIdx.x; asm volatile("" : "+v"(t)); return t; }
__device__ __forceinline__ int lbid() { int b = blockIdx.x; asm volatile("" : "+s"(b)); return b; }

__device__ __forceinline__ float bf2f(bf16_t h) { return __uint_as_float(((unsigned)h) << 16); }
typedef __bf16 bf16x2_t __attribute__((ext_vector_type(2)));
typedef float f32x2_t __attribute__((ext_vector_type(2)));
__device__ __forceinline__ unsigned pack2(float lo, float hi) { const f32x2_t v = {lo, hi}; const bf16x2_t b = __builtin_convertvector(v, bf16x2_t); return __builtin_bit_cast(unsigned, b); }
__device__ __forceinline__ bf16_t f2bf(float f) { return (bf16_t)(pack2(f, 0.f) & 0xffffu); }
__device__ __forceinline__ float sigmoid_f(float x) { return __builtin_amdgcn_rcpf(1.f + __expf(-x)); }
__device__ __forceinline__ float silu_f(float x) { return x * __builtin_amdgcn_rcpf(1.f + __expf(-x)); }
__device__ __forceinline__ float softplus_f(float x) { return fmaxf(x, 0.f) + log1pf(__expf(-fabsf(x))); }

template <int CTRL> __device__ __forceinline__ float dpp_f(float x) {
  return __int_as_float(__builtin_amdgcn_update_dpp(0, __float_as_int(x), CTRL, 0xF, 0xF, true));
}
__device__ __forceinline__ float sum4(float x) { x += dpp_f<0xB1>(x); x += dpp_f<0x4E>(x); return x; }
__device__ __forceinline__ float sum8(float x) { x = sum4(x); x += dpp_f<0x141>(x); return x; }
__device__ __forceinline__ float sum16(float x) { x = sum8(x); x += dpp_f<0x140>(x); return x; }
__device__ __forceinline__ float wave_sum63(float x) {
  x = sum16(x);
  x += __int_as_float(__builtin_amdgcn_update_dpp(0, __float_as_int(x), 0x142, 0xA, 0xF, false));
  x += __int_as_float(__builtin_amdgcn_update_dpp(0, __float_as_int(x), 0x143, 0xC, 0xF, false));
  return x;
}

__device__ __forceinline__ float wave_sum(float x) {
#pragma unroll
  for (int o = 32; o > 0; o >>= 1) x += __shfl_xor(x, o);
  return x;
}

__device__ __forceinline__ void mods_phase(const P& p_unused, char* smem) {
  const P& p = params();
  float* red = (float*)smem;
  float* mods = (float*)(p.ws + OFF_MODS);
  const int tid = ltid(), kq = tid >> 6, col = tid & 63;
  for (int it = lbid(); it < 192; it += gridDim.x) {
    const int l = it / 48, j0 = (it % 48) * 64;
    const float* w = p.ada_w + (size_t)l * 1024 * 3072 + j0 + col;
    float aL = 0.f, aC = 0.f;
    for (int k = kq * 256; k < kq * 256 + 256; ++k) {
      const float wv = w[(size_t)k * 3072];
      aL += silu_f(p.c[k]) * wv;
      aC += silu_f(p.c_ctx[k]) * wv;
    }
    red[(kq * 64 + col) * 2] = aL; red[(kq * 64 + col) * 2 + 1] = aC;
    __syncthreads();
    if (tid < 128) {
      const int cc = tid & 63, which = tid >> 6;
      float s = red[cc * 2 + which] + red[(64 + cc) * 2 + which] + red[(128 + cc) * 2 + which] + red[(192 + cc) * 2 + which];
      mods[(l * 2 + which) * 3072 + j0 + cc] = s + p.ada_b[l * 3072 + j0 + cc];
    }
    __syncthreads();
  }
}

__device__ __forceinline__ void transpose_seg(const float* src, int ldsrc, int K, int src_col0, int len, bf16_t* dst, int dst_row0, int padlen, char* smem) {
  float* tile = (float*)smem;
  const int tid = ltid();
  const int nkt = K / 64, nnt = padlen / 64;
  for (int it = lbid(); it < nkt * nnt; it += gridDim.x) {
    const int nt = it / nkt, kt = it % nkt;
    const int nn4 = (tid & 15) * 4;
#pragma unroll
    for (int i = 0; i < 4; ++i) {
      const int kk = (tid >> 4) + 16 * i;
      f32x4 v = {0.f, 0.f, 0.f, 0.f};
      if (nt * 64 + nn4 < len) v = *(const f32x4*)(src + (size_t)(kt * 64 + kk) * ldsrc + src_col0 + nt * 64 + nn4);
      tile[kk * 65 + nn4] = v[0]; tile[kk * 65 + nn4 + 1] = v[1]; tile[kk * 65 + nn4 + 2] = v[2]; tile[kk * 65 + nn4 + 3] = v[3];
    }
    __syncthreads();
    {
      const int nn = tid >> 2, kq = (tid & 3) * 16;
      u32x4 o0, o1;
      o0[0] = pack2(tile[(kq + 0) * 65 + nn], tile[(kq + 1) * 65 + nn]);
      o0[1] = pack2(tile[(kq + 2) * 65 + nn], tile[(kq + 3) * 65 + nn]);
      o0[2] = pack2(tile[(kq + 4) * 65 + nn], tile[(kq + 5) * 65 + nn]);
      o0[3] = pack2(tile[(kq + 6) * 65 + nn], tile[(kq + 7) * 65 + nn]);
      o1[0] = pack2(tile[(kq + 8) * 65 + nn], tile[(kq + 9) * 65 + nn]);
      o1[1] = pack2(tile[(kq + 10) * 65 + nn], tile[(kq + 11) * 65 + nn]);
      o1[2] = pack2(tile[(kq + 12) * 65 + nn], tile[(kq + 13) * 65 + nn]);
      o1[3] = pack2(tile[(kq + 14) * 65 + nn], tile[(kq + 15) * 65 + nn]);
      bf16_t* d = dst + (size_t)(dst_row0 + nt * 64 + nn) * K + kt * 64 + kq;
      *(u32x4*)d = o0; *(u32x4*)(d + 8) = o1;
    }
    __syncthreads();
  }
}

__device__ __forceinline__ void transposes_for_layer(const P& p_unused, int l, int stage, char* smem) {
  const P& p = params();
  bf16_t* W = (bf16_t*)(p.ws + OFF_R) + E_ELEMS;
  bf16_t* WO = (bf16_t*)(p.ws + OFF_WO);
  const int j = l >> 1;
  const bool ab = (l & 1) == 0;
  const float* win = ab ? p.ab_w_in + (size_t)j * 1024 * 4896 : p.cd_w_in + (size_t)j * 1024 * 7696;
  const float* wout = ab ? p.ab_w_out + (size_t)j * 1536 * 1024 : p.cd_w_out + (size_t)j * 2048 * 1024;
  const int ldw = ab ? 4896 : 7696;
  for (int s = 0; s < 6; ++s) {
    const float* src = win; int ldsrc = ldw, K = 1024, col0 = 0, len = 0, row0 = 0, pad = 0; bf16_t* dst = W;
    if (ab) {
      if (s == 0) { col0 = 3872; len = 1024; row0 = 0; pad = 1024; }
      else if (s == 1) { col0 = 2304; len = 1536; row0 = 1024; pad = 1536; }
      else if (s == 2) { col0 = 3840; len = 32; row0 = 2560; pad = 128; }
      else if (s == 3) { col0 = 0; len = 2304; row0 = 2688; pad = 2304; }
      else if (s == 4) { src = wout; ldsrc = 1024; K = 1536; col0 = 0; len = 1024; row0 = 0; pad = 1024; dst = WO; }
    } else if (stage == 0) {
      if (s == 0) { col0 = 4112; len = 1024; row0 = 0; pad = 1024; }
      else if (s == 1) { col0 = 0; len = 2048; row0 = 1024; pad = 2048; }
      else if (s == 2) { col0 = 2048; len = 1024; row0 = 3072; pad = 1024; }
      else if (s == 3) { col0 = 3072; len = 1024; row0 = 4096; pad = 1024; }
      else if (s == 4) { col0 = 4096; len = 16; row0 = 5120; pad = 128; }
      else { src = wout; ldsrc = 1024; K = 2048; col0 = 0; len = 1024; row0 = 0; pad = 1024; dst = WO; }
    } else {
      if (s == 0) { col0 = 6672; len = 1024; row0 = 0; pad = 1024; }
      else if (s == 1) { col0 = 5136; len = 1024; row0 = 1024; pad = 1024; }
      else if (s == 2) { col0 = 6160; len = 512; row0 = 2048; pad = 512; }
    }
    if (pad > 0) transpose_seg(src, ldsrc, K, col0, len, dst, row0, pad, smem);
  }
}

__device__ __forceinline__ void norm_phase(const P& p_unused, int l) {
  const P& p = params();
  const int tid_ = ltid(); const int lane = tid_ & 63, wv = tid_ >> 6;
  if ((l & 1) == 0) {
    u32x4* z = (u32x4*)((bf16_t*)(p.ws + OFF_U) + (E_ELEMS * 19) / 4);
    for (int i = lbid() * 256 + tid_; i < MT * 64; i += gridDim.x * 256) z[i] = (u32x4){0u, 0u, 0u, 0u};
  }
  bf16_t* H = (bf16_t*)(p.ws + OFF_R);
  const float* mods = (const float*)(p.ws + OFF_MODS);
  const float* g = p.norm_g + l * 1024;
  for (int row = lbid() * 4 + wv; row < MT; row += gridDim.x * 4) {
    const bool isc = row >= TL;
    const float* src = isc ? ((l == 0 ? p.ctx : (const float*)(p.ws + OFF_CTXS)) + (size_t)(row - TL) * 1024)
                           : ((l == 0 ? p.x : p.out) + (size_t)row * 1024);
    const float* md = mods + (l * 2 + (isc ? 1 : 0)) * 3072;
    f32x4 v[4]; float ss = 0.f;
#pragma unroll
    for (int i = 0; i < 4; ++i) { v[i] = *(const f32x4*)(src + i * 256 + lane * 4); ss += v[i][0] * v[i][0] + v[i][1] * v[i][1] + v[i][2] * v[i][2] + v[i][3] * v[i][3]; }
    ss = wave_sum(ss);
    const float rs = rsqrtf(ss * (1.f / 1024.f) + 1e-6f);
#pragma unroll
    for (int i = 0; i < 4; ++i) {
      const int c = i * 256 + lane * 4;
      const f32x4 gg = *(const f32x4*)(g + c), sh = *(const f32x4*)(md + c), sc = *(const f32x4*)(md + 1024 + c);
      float o0 = v[i][0] * rs * gg[0] * (1.f + sc[0]) + sh[0];
      float o1 = v[i][1] * rs * gg[1] * (1.f + sc[1]) + sh[1];
      float o2 = v[i][2] * rs * gg[2] * (1.f + sc[2]) + sh[2];
      float o3 = v[i][3] * rs * gg[3] * (1.f + sc[3]) + sh[3];
      u32x2 o; o[0] = pack2(o0, o1); o[1] = pack2(o2, o3);
      *(u32x2*)(H + (size_t)row * 1024 + c) = o;
    }
  }
}

__device__ __forceinline__ void gemm_phase(const P& p_unused, int kind, int l, char* smem) {
  const P& p = params();
  const int tid = ltid(), lane = tid & 63, wv = tid >> 6, wr = wv >> 1, wc = wv & 1, fr = lane & 15, fq = lane >> 4;
  bf16_t* sA = (bf16_t*)smem;
  bf16_t* sB = sA + 128 * 72;
  bf16_t* Ub = (bf16_t*)(p.ws + OFF_U);
  const bf16_t* Wbase = (const bf16_t*)(p.ws + OFF_R) + E_ELEMS;
  const bf16_t *A1, *A2, *Wt; int ld1, ld2, K1, K, ntN;
  A1 = (const bf16_t*)(p.ws + OFF_R); ld1 = 1024; A2 = A1; ld2 = 1024; K1 = 1024; K = 1024; Wt = Wbase; ntN = 39;
  if (kind == 1) { Wt = Wbase + (size_t)2688 * 1024; ntN = 18; }
  else if (kind == 2) { ntN = 41; }
  else if (kind == 3) { ntN = 20; }
  else if (kind == 4) {
    Wt = (const bf16_t*)(p.ws + OFF_WO); ntN = 8; K = 2048;
    if ((l & 1) == 0) { A1 = Ub + E_ELEMS + 1792; ld1 = 2304; A2 = Ub; ld2 = 1024; K1 = 512; K = 1536; }
    else { A1 = Ub; ld1 = 1024; A2 = Ub + E_ELEMS; ld2 = 1024; }
  }
  const float* mods = (const float*)(p.ws + OFF_MODS);
  const int ntiles = ((kind == 4 && l == 3) ? TL / 128 : MT / 128) * ntN;
  for (int tile = lbid(); tile < ntiles; tile += gridDim.x) {
    const int tm = tile / ntN, tn = tile % ntN;
    f32x4 acc[4][4];
#pragma unroll
    for (int a = 0; a < 4; ++a)
#pragma unroll
      for (int b = 0; b < 4; ++b) acc[a][b] = (f32x4){0.f, 0.f, 0.f, 0.f};
    u32x4 ra[4], rb[4];
    {
#pragma unroll
      for (int i = 0; i < 4; ++i) {
        const int id = tid + 256 * i, r = id >> 3, kc = (id & 7) * 8;
        ra[i] = *(const u32x4*)(A1 + (size_t)(tm * 128 + r) * ld1 + kc);
        rb[i] = *(const u32x4*)(Wt + (size_t)(tn * 128 + r) * K + kc);
      }
    }
    for (int k0 = 0; k0 < K; k0 += 64) {
      __syncthreads();
#pragma unroll
      for (int i = 0; i < 4; ++i) {
        const int id = tid + 256 * i, r = id >> 3, kc = (id & 7) * 8;
        *(u32x4*)(sA + r * 72 + kc) = ra[i];
        *(u32x4*)(sB + r * 72 + kc) = rb[i];
      }
      __syncthreads();
      if (k0 + 64 < K) {
        const int kn = k0 + 64;
        const bf16_t* Ap; int ldp, kk;
        if (kn < K1) { Ap = A1; ldp = ld1; kk = kn; } else { Ap = A2; ldp = ld2; kk = kn - K1; }
#pragma unroll
        for (int i = 0; i < 4; ++i) {
          const int id = tid + 256 * i, r = id >> 3, kc = (id & 7) * 8;
          ra[i] = *(const u32x4*)(Ap + (size_t)(tm * 128 + r) * ldp + kk + kc);
          rb[i] = *(const u32x4*)(Wt + (size_t)(tn * 128 + r) * K + kn + kc);
        }
      }
#pragma unroll
      for (int ks = 0; ks < 2; ++ks) {
        bf16x8 af[4], bfr[4];
#pragma unroll
        for (int m = 0; m < 4; ++m) af[m] = *(const bf16x8*)(sA + (wr * 64 + m * 16 + fr) * 72 + ks * 32 + fq * 8);
#pragma unroll
        for (int n = 0; n < 4; ++n) bfr[n] = *(const bf16x8*)(sB + (wc * 64 + n * 16 + fr) * 72 + ks * 32 + fq * 8);
#pragma unroll
        for (int m = 0; m < 4; ++m)
#pragma unroll
          for (int n = 0; n < 4; ++n) acc[m][n] = __builtin_amdgcn_mfma_f32_16x16x32_bf16(af[m], bfr[n], acc[m][n], 0, 0, 0);
      }
    }
    if (kind == 4) {
      const float* gl = mods + (l * 2 + 0) * 3072 + 2048;
      const float* gc = mods + (l * 2 + 1) * 3072 + 2048;
      const float* xin = (l == 0) ? p.x : p.out;
      const float* cin = (l == 0) ? p.ctx : (const float*)(p.ws + OFF_CTXS);
      float* cout = (float*)(p.ws + OFF_CTXS);
#pragma unroll
      for (int m = 0; m < 4; ++m)
#pragma unroll
        for (int n = 0; n < 4; ++n) {
          const int col = tn * 128 + wc * 64 + n * 16 + fr;
#pragma unroll
          for (int jj = 0; jj < 4; ++jj) {
            const int row = tm * 128 + wr * 64 + m * 16 + fq * 4 + jj;
            if (row < TL) p.out[(size_t)row * 1024 + col] = xin[(size_t)row * 1024 + col] + gl[col] * acc[m][n][jj];
            else cout[(size_t)(row - TL) * 1024 + col] = cin[(size_t)(row - TL) * 1024 + col] + gc[col] * acc[m][n][jj];
          }
        }
    } else {
      bf16_t* out = Ub; int ld = 1024, cbase = 0, valid = 128 * 64; float* fout = nullptr; int fld = 0;
      float* fside = (float*)(p.ws + OFF_FSIDE);
      if (kind == 0) {
        if (tn < 8) { out = Ub; ld = 1024; cbase = tn * 128; valid = 1024; }
        else if (tn < 20) { out = Ub + (E_ELEMS * 13) / 4; ld = 1536; cbase = (tn - 8) * 128; valid = 1536; }
        else if (tn == 20) { fout = fside; fld = 32; cbase = 0; valid = 32; }
        else { out = Ub + E_ELEMS; ld = 2304; cbase = (tn - 21) * 128; valid = 2304; }
      } else if (kind == 1) { out = Ub + E_ELEMS; ld = 2304; cbase = tn * 128; valid = 2304; }
      else if (kind == 2) {
        if (tn < 8) { out = Ub; ld = 1024; cbase = tn * 128; valid = 1024; }
        else if (tn < 24) { out = Ub + E_ELEMS; ld = 2048; cbase = (tn - 8) * 128; valid = 2048; }
        else if (tn < 32) { out = Ub + 3 * E_ELEMS; ld = 1024; cbase = (tn - 24) * 128; valid = 1024; }
        else if (tn < 40) { out = Ub + 4 * E_ELEMS; ld = 1024; cbase = (tn - 32) * 128; valid = 1024; }
        else { fout = fside; fld = 16; cbase = 0; valid = 16; }
      } else {
        if (tn < 8) { out = Ub + E_ELEMS; ld = 1024; cbase = tn * 128; valid = 1024; }
        else if (tn < 16) { out = Ub + 2 * E_ELEMS; ld = 1024; cbase = (tn - 8) * 128; valid = 1024; }
        else { out = Ub + 3 * E_ELEMS; ld = 512; cbase = (tn - 16) * 128; valid = 512; }
      }
#pragma unroll
      for (int m = 0; m < 4; ++m)
#pragma unroll
        for (int n = 0; n < 4; ++n) {
          const int col = cbase + wc * 64 + n * 16 + fr;
          if (col < valid) {
#pragma unroll
            for (int jj = 0; jj < 4; ++jj) {
              const int row = tm * 128 + wr * 64 + m * 16 + fq * 4 + jj;
              if (fout) fout[(size_t)row * fld + col] = (kind == 0) ? softplus_f(acc[m][n][jj] + p.mb_dt_bias[(l >> 1) * 32 + col]) : acc[m][n][jj];
              else out[(size_t)row * ld + col] = f2bf(acc[m][n][jj]);
            }
          }
        }
    }
  }
}

__device__ __forceinline__ void chunk_pos(int ci, int dir, int& rbase, int& t0, int& Ls) {
  const bool isc = ci < 8;
  int cidx = isc ? ci : ci - 8;
  const int nseg = isc ? 8 : 512;
  if (dir) cidx = nseg - 1 - cidx;
  Ls = isc ? TC : TL; rbase = isc ? TL : 0; t0 = cidx * 32;
}

#define LDS_BARRIER() do { asm volatile("s_waitcnt lgkmcnt(0)" ::: "memory"); __builtin_amdgcn_s_barrier(); } while (0)

__device__ __forceinline__ void rwkv_scan(const P& p_unused, int j, char* smem, int bid) {
  const P& p = params();
  const int tid = ltid(), lane = tid & 63, wv = tid >> 6, fr = lane & 15, fq = lane >> 4;
  const int dir = bid >> 5, head = (bid >> 2) & 7, qr = bid & 3;
  float* sR = (float*)smem;
  float* sK = sR + 2048;
  float* sW = sK + 2048;
  float* sKK = sW + 2048;
  float* sKA = sKK + 2048;
  float* sV = sKA + 2048;
  float* sY = sV + 512;
  bf16_t* sTW = (bf16_t*)(sY + 512);
  bf16_t* sAL = sTW + 32 * 72;
  float* sP = (float*)(sAL + 32 * 72);
  float* sDum = sP + 32 * 128;
  const bf16_t* U = (const bf16_t*)(p.ws + OFF_U) + E_ELEMS;
  bf16_t* ysum = (bf16_t*)(p.ws + OFF_U) + (E_ELEMS * 19) / 4;
  float* bonus = (float*)(p.ws + OFF_BONUS) + (size_t)dir * MT * 8;
  const float* mu = p.rk_mu + j * 1792;
  const float* w0 = p.rk_w0 + (j * 2 + dir) * 512 + head * 64;
  const float* a0 = p.rk_a0 + (j * 2 + dir) * 512 + head * 64;
  const float* kkw = p.rk_k_k + j * 512 + head * 64;
  const float* kaw = p.rk_k_a + j * 512 + head * 64;
  const float* rkw = p.rk_r_k + j * 512 + head * 64;
  const int path = wv >> 1, mt = wv & 1;
  const float* l2 = (path ? p.rk_a2 : p.rk_w2) + (size_t)(j * 2 + dir) * 64 * 512 + head * 64;
  bf16x8 bfrag[4][2];
#pragma unroll
  for (int nt = 0; nt < 4; ++nt)
#pragma unroll
    for (int ks = 0; ks < 2; ++ks)
#pragma unroll
      for (int jj = 0; jj < 8; ++jj) bfrag[nt][ks][jj] = (short)f2bf(l2[(size_t)(ks * 32 + fq * 8 + jj) * 512 + nt * 16 + fr]);
  const int ccA = (tid & 127) * 2, hA = tid >> 7;
  const int ttB = tid >> 3, ccB = (tid & 7) * 2;
  int gcA;
  if (ccA < 64) gcA = head * 64 + ccA; else if (ccA < 128) gcA = 512 + head * 64 + ccA - 64;
  else if (ccA < 192) gcA = 1536 + dir * 64 + ccA - 128; else gcA = 1664 + dir * 64 + ccA - 192;
  const float muA0 = mu[gcA], muA1 = mu[gcA + 1];
  const float muB0 = mu[1024 + head * 64 + qr * 16 + ccB], muB1 = mu[1024 + head * 64 + qr * 16 + ccB + 1];
  float cB[4];
#pragma unroll
  for (int nt = 0; nt < 4; ++nt) cB[nt] = (path ? a0 : w0)[nt * 16 + fr];
  float cKK[4], cKA[4], cRK[4];
#pragma unroll
  for (int i = 0; i < 4; ++i) { const int col = i * 16 + (tid & 15); cKK[i] = kkw[col]; cKA[i] = kaw[col]; cRK[i] = rkw[col]; }
  u32x4 pre[5];
#define RWKV_ISSUE(CI)                                                                                   \
  {                                                                                                      \
    int rb_, t0_, Ls_; chunk_pos((CI), dir, rb_, t0_, Ls_);                                              \
    _Pragma("unroll") for (int i = 0; i < 5; ++i) {                                                      \
      const int idx = tid + 256 * i;                                                                     \
      pre[i] = (u32x4){0u, 0u, 0u, 0u};                                                                  \
      if (idx < 1088) {                                                                                  \
        const int row = idx / 34, v = idx - row * 34, t = t0_ + row;                                     \
        int gc;                                                                                          \
        if (v < 8) gc = head * 64 + v * 8; else if (v < 16) gc = 512 + head * 64 + (v - 8) * 8;          \
        else if (v < 24) gc = 1536 + dir * 64 + (v - 16) * 8; else if (v < 32) gc = 1664 + dir * 64 + (v - 24) * 8; \
        else gc = 1024 + head * 64 + qr * 16 + (v - 32) * 8;                                             \
        if (t >= 0 && t < Ls_) pre[i] = *(const u32x4*)(U + (size_t)(rb_ + t) * 2304 + gc);             \
      }                                                                                                  \
    }                                                                                                    \
  }
#define RWKV_COMMIT()                                                                                    \
  {                                                                                                      \
    _Pragma("unroll") for (int i = 0; i < 5; ++i) {                                                      \
      const int idx = tid + 256 * i;                                                                     \
      if (idx < 1088) {                                                                                  \
        const int row = idx / 34, v = idx - row * 34;                                                    \
        if (v >= 16 && v < 32) *(u32x4*)(((v < 24) ? sTW + row * 72 + (v - 16) * 8 : sAL + row * 72 + (v - 24) * 8)) = pre[i]; \
        else {                                                                                           \
          float* d = (v < 8) ? sR + row * 64 + v * 8 : ((v < 16) ? sK + row * 64 + (v - 8) * 8 : sV + row * 16 + (v - 32) * 8); \
          f32x4 lo, hi;                                                                                  \
          lo[0] = __uint_as_float(pre[i][0] << 16); lo[1] = __uint_as_float(pre[i][0] & 0xffff0000u);    \
          lo[2] = __uint_as_float(pre[i][1] << 16); lo[3] = __uint_as_float(pre[i][1] & 0xffff0000u);    \
          hi[0] = __uint_as_float(pre[i][2] << 16); hi[1] = __uint_as_float(pre[i][2] & 0xffff0000u);    \
          hi[2] = __uint_as_float(pre[i][3] << 16); hi[3] = __uint_as_float(pre[i][3] & 0xffff0000u);    \
          *(f32x4*)d = lo; *(f32x4*)(d + 4) = hi;                                                        \
        }                                                                                                \
      }                                                                                                  \
    }                                                                                                    \
  }
  RWKV_ISSUE(0);
  RWKV_COMMIT();
  __syncthreads();
  typedef float f32x2v __attribute__((ext_vector_type(2)));
  f32x2v SA = {0.f, 0.f}, SB = {0.f, 0.f};
  for (int ci = 0; ci < 520; ++ci) {
    int rbase, t0, Ls; chunk_pos(ci, dir, rbase, t0, Ls);
    {
      const bf16_t* sX = path ? sAL : sTW;
      f32x4 acc[4];
#pragma unroll
      for (int nt = 0; nt < 4; ++nt) acc[nt] = (f32x4){0.f, 0.f, 0.f, 0.f};
#pragma unroll
      for (int ks = 0; ks < 2; ++ks) {
        const bf16x8 a = *(const bf16x8*)(sX + (mt * 16 + fr) * 72 + ks * 32 + fq * 8);
#pragma unroll
        for (int nt = 0; nt < 4; ++nt) acc[nt] = __builtin_amdgcn_mfma_f32_16x16x32_bf16(a, bfrag[nt][ks], acc[nt], 0, 0, 0);
      }
#pragma unroll
      for (int nt = 0; nt < 4; ++nt)
#pragma unroll
        for (int jj = 0; jj < 4; ++jj) {
          const int tok = mt * 16 + fq * 4 + jj, col = nt * 16 + fr;
          const float v = acc[nt][jj];
          if (path == 0) { const float sg = sigmoid_f(cB[nt] + v); sW[tok * 64 + col] = __expf(-0.6065306597f * sg); }
          else sKA[tok * 64 + col] = sigmoid_f(cB[nt] + v);
        }
    }
    LDS_BARRIER();
    {
      const int part = tid & 15;
#pragma unroll
      for (int ps = 0; ps < 2; ++ps) {
        const int tt = ps * 16 + (tid >> 4);
        float kk[4], aa[4]; float ss = 0.f, bon = 0.f;
#pragma unroll
        for (int i = 0; i < 4; ++i) {
          const int col = i * 16 + part;
          const float k = sK[tt * 64 + col], a = sKA[tt * 64 + col], r = sR[tt * 64 + col];
          const float kv = k * cKK[i];
          kk[i] = kv; aa[i] = a; ss += kv * kv;
          const float kd = k * (1.f + (a - 1.f) * cKA[i]);
          sK[tt * 64 + col] = kd;
          bon += r * kd * cRK[i];
        }
        ss = sum16(ss); bon = sum16(bon);
        const float inv = __builtin_amdgcn_rcpf(fmaxf(__builtin_amdgcn_sqrtf(ss), 1e-12f));
#pragma unroll
        for (int i = 0; i < 4; ++i) {
          const int col = i * 16 + part;
          const float kn = kk[i] * inv;
          sKK[tt * 64 + col] = kn; sKA[tt * 64 + col] = kn * aa[i];
        }
        if (part == 0 && qr == 0) bonus[(size_t)(rbase + t0 + tt) * 8 + head] = bon;
      }
    }
    LDS_BARRIER();
    if (ci + 1 < 520) RWKV_ISSUE(ci + 1);
    {
      const int vr = tid >> 4, pp = tid & 15;
#define RW_LOAD(TT, R4, KD4, W4, KK4, KA4, VV)                                                          \
      R4 = *(const f32x4*)(sR + (TT) * 64 + pp * 4); KD4 = *(const f32x4*)(sK + (TT) * 64 + pp * 4);    \
      W4 = *(const f32x4*)(sW + (TT) * 64 + pp * 4); KK4 = *(const f32x4*)(sKK + (TT) * 64 + pp * 4);   \
      KA4 = *(const f32x4*)(sKA + (TT) * 64 + pp * 4); VV = sV[(TT) * 16 + vr];
#define RW_SCAN(TTOF)                                                                                   \
      {                                                                                                 \
        f32x4 r4, kd4, w4, kk4, ka4; float vv;                                                          \
        f32x4 mr4, mkd4, mw4, mkk4, mka4; float mvv;     \
        RW_LOAD(TTOF(0), r4, kd4, w4, kk4, ka4, vv)                                                     \
        RW_LOAD(TTOF(1), mr4, mkd4, mw4, mkk4, mka4, mvv)                                               \
        _Pragma("unroll") for (int s = 0; s < 32; ++s) {                                                \
          f32x4 nr4 = mr4, nkd4 = mkd4, nw4 = mw4, nkk4 = mkk4, nka4 = mka4; float nvv = mvv;           \
          if (s + 2 < 32) { RW_LOAD(TTOF(s + 2), mr4, mkd4, mw4, mkk4, mka4, mvv) }                     \
          const f32x2v kkA = {kk4[0], kk4[1]}, kkB = {kk4[2], kk4[3]}, wA = {w4[0], w4[1]}, wB = {w4[2], w4[3]};      \
          const f32x2v kaA = {ka4[0], ka4[1]}, kaB = {ka4[2], ka4[3]}, kdA = {kd4[0], kd4[1]}, kdB = {kd4[2], kd4[3]};  \
          const f32x2v rA = {r4[0], r4[1]}, rB = {r4[2], r4[3]};                                          \
          f32x2v td = SA * kkA; td = SB * kkB + td;                                                       \
          float d = td[0] + td[1];                                                                      \
          const f32x2v vv2 = {vv, vv};                                                                    \
          const f32x2v uA = vv2 * kdA + SA * wA, uB = vv2 * kdB + SB * wB;     \
          d = sum16(d);                                                                                 \
          const f32x2v nd2 = {-d, -d};                                                                    \
          SA = nd2 * kaA + uA;                                                                            \
          SB = nd2 * kaB + uB;                                                                            \
          f32x2v ty = SA * rA; ty = SB * rB + ty;                                                         \
          float y = ty[0] + ty[1];                                                                      \
          y += dpp_f<0xB1>(y);                                                                          \
          *(((pp & 1) == 0) ? (sP + TTOF(s) * 128 + (tid >> 1)) : (sDum + lane)) = y;                   \
          r4 = nr4; kd4 = nkd4; w4 = nw4; kk4 = nkk4; ka4 = nka4; vv = nvv;                             \
        }                                                                                               \
      }
#define TT_FWD(S) (S)
#define TT_BWD(S) (31 - (S))
      if (dir) RW_SCAN(TT_BWD) else RW_SCAN(TT_FWD)
#undef RW_LOAD
#undef RW_SCAN
    }
    LDS_BARRIER();
    {
      const int tt = tid >> 3, pr = (tid & 7) * 2;
      typedef short s2_t __attribute__((ext_vector_type(2)));
      const float* pq = sP + tt * 128 + pr * 8;
      const f32x4 q0 = *(const f32x4*)pq, q1 = *(const f32x4*)(pq + 4), q2 = *(const f32x4*)(pq + 8), q3 = *(const f32x4*)(pq + 12);
      const unsigned pk = pack2(((q0[0] + q0[1]) + (q0[2] + q0[3])) + ((q1[0] + q1[1]) + (q1[2] + q1[3])),
                                ((q2[0] + q2[1]) + (q2[2] + q2[3])) + ((q3[0] + q3[1]) + (q3[2] + q3[3])));
      __builtin_amdgcn_global_atomic_fadd_v2bf16((s2_t __attribute__((address_space(1)))*)(ysum + (size_t)(rbase + t0 + tt) * 512 + head * 64 + qr * 16 + pr),
                                                 __builtin_bit_cast(s2_t, pk));
    }
    if (ci + 1 < 520) RWKV_COMMIT();
    LDS_BARRIER();
  }
#undef RWKV_ISSUE
#undef RWKV_COMMIT
}

__device__ __forceinline__ void unpack8(const u32x4 v, float* x) {
#pragma unroll
  for (int e = 0; e < 4; ++e) { x[2 * e] = __uint_as_float(v[e] << 16); x[2 * e + 1] = __uint_as_float(v[e] & 0xffff0000u); }
}
__device__ __forceinline__ void rwkv_post(const P& p_unused, int j) {
  const P& p = params();
  const int tid_ = ltid(); const int lane = tid_ & 63, wv = tid_ >> 6;
  bf16_t* U = (bf16_t*)(p.ws + OFF_U) + E_ELEMS;
  const bf16_t* ys = (const bf16_t*)(p.ws + OFF_U) + (E_ELEMS * 19) / 4;
  const float* bonf = (const float*)(p.ws + OFF_BONUS);
  const float* bonb = bonf + (size_t)MT * 8;
  const int c0 = lane * 8, head = lane >> 3;
  float mu[8], lw[8], lb[8];
  {
    const float* mup = p.rk_mu + j * 1792 + 1024 + c0; const float* lwp = p.rk_ln_w + j * 512 + c0; const float* lbp = p.rk_ln_b + j * 512 + c0;
#pragma unroll
    for (int i = 0; i < 8; ++i) { mu[i] = mup[i]; lw[i] = lwp[i]; lb[i] = lbp[i]; }
  }
  for (int row = lbid() * 4 + wv; row < MT; row += gridDim.x * 4) {
    const int t = row < TL ? row : row - TL; const int Ls = row < TL ? TL : TC;
    bf16_t* urow = U + (size_t)row * 2304;
    float y[8], v0[8], vm[8], vp[8], ga[8];
    unpack8(*(const u32x4*)(ys + (size_t)row * 512 + c0), y);
    unpack8(*(const u32x4*)(urow + 1024 + c0), v0);
    unpack8(*(const u32x4*)(urow + 1792 + c0), ga);
    const u32x4 zero = {0u, 0u, 0u, 0u};
    unpack8((t > 0) ? *(const u32x4*)(urow + 1024 + c0 - 2304) : zero, vm);
    unpack8((t < Ls - 1) ? *(const u32x4*)(urow + 1024 + c0 + 2304) : zero, vp);
    float sm = 0.f;
#pragma unroll
    for (int i = 0; i < 8; ++i) sm += y[i];
    sm = sum8(sm);
    const float mean = sm * (1.f / 64.f);
    float vs = 0.f;
#pragma unroll
    for (int i = 0; i < 8; ++i) { const float d = y[i] - mean; vs += d * d; }
    vs = sum8(vs);
    const float rstd = rsqrtf(vs * (1.f / 64.f) + 64e-5f);
    const float bon = bonf[(size_t)row * 8 + head] + bonb[(size_t)row * 8 + head];
    float o[8];
#pragma unroll
    for (int i = 0; i < 8; ++i) {
      o[i] = ((y[i] - mean) * rstd * lw[i] + lb[i] + bon * v0[i]) * silu_f(ga[i]);
    }
    u32x4 ov; ov[0] = pack2(o[0], o[1]); ov[1] = pack2(o[2], o[3]); ov[2] = pack2(o[4], o[5]); ov[3] = pack2(o[6], o[7]);
    *(u32x4*)(urow + 1792 + c0) = ov;
  }
}

__device__ __forceinline__ void mamba_scan(const P& p_unused, int j, char* smem, int bid) {
  const P& p = params();
  const int tid = ltid();
  const int dir = bid >> 6, head = (bid >> 2) & 15, qr = bid & 3, g = head >> 3;
  float* sB = (float*)smem;
  float* sC = sB + 4096;
  float* sX = sC + 4096;
  float* sDA = sX + 512;
  float* sDT = sDA + 32;
  float* sY = sDT + 32;
  float* sDum = sY + 512;
  float* sP = sDum + 64;
  const bf16_t* XBC = (const bf16_t*)(p.ws + OFF_U) + (E_ELEMS * 13) / 4;
  const float* fs = (const float*)(p.ws + OFF_FSIDE);
  bf16_t* ydir = (bf16_t*)(p.ws + OFF_R) + (size_t)dir * E_ELEMS;
  const float Aneg = -__expf(p.mb_a_log[(j * 2 + dir) * 16 + head]);
  const int ccA = (tid & 127) * 2, hA = tid >> 7;
  const int ttB = tid >> 3, ccB = 256 + (tid & 7) * 2;
  u32x4 pre[5]; float predt = 0.f;
#define MB_ISSUE(CI)                                                                                     \
  {                                                                                                      \
    int rb_, t0_, Ls_; chunk_pos((CI), dir, rb_, t0_, Ls_);                                              \
    _Pragma("unroll") for (int i = 0; i < 5; ++i) {                                                      \
      const int idx = tid + 256 * i;                                                                     \
      pre[i] = (u32x4){0u, 0u, 0u, 0u};                                                                  \
      if (idx < 1088) {                                                                                  \
        const int row = idx / 34, v = idx - row * 34;                                                    \
        const int gc = (v < 2) ? head * 64 + qr * 16 + v * 8 : ((v < 18) ? 1024 + g * 128 + (v - 2) * 8 : 1280 + g * 128 + (v - 18) * 8); \
        pre[i] = *(const u32x4*)(XBC + (size_t)(rb_ + t0_ + row) * 1536 + gc);                           \
      }                                                                                                  \
    }                                                                                                    \
    if (tid < 32) predt = fs[(size_t)(rb_ + t0_ + tid) * 32 + dir * 16 + head];                          \
  }
#define MB_COMMIT()                                                                                      \
  {                                                                                                      \
    _Pragma("unroll") for (int i = 0; i < 5; ++i) {                                                      \
      const int idx = tid + 256 * i;                                                                     \
      if (idx < 1088) {                                                                                  \
        const int row = idx / 34, v = idx - row * 34;                                                    \
        float* d = (v < 2) ? sX + row * 16 + v * 8 : ((v < 18) ? sB + row * 128 + (v - 2) * 8 : sC + row * 128 + (v - 18) * 8); \
        f32x4 lo, hi;                                                                                    \
        lo[0] = __uint_as_float(pre[i][0] << 16); lo[1] = __uint_as_float(pre[i][0] & 0xffff0000u);      \
        lo[2] = __uint_as_float(pre[i][1] << 16); lo[3] = __uint_as_float(pre[i][1] & 0xffff0000u);      \
        hi[0] = __uint_as_float(pre[i][2] << 16); hi[1] = __uint_as_float(pre[i][2] & 0xffff0000u);      \
        hi[2] = __uint_as_float(pre[i][3] << 16); hi[3] = __uint_as_float(pre[i][3] & 0xffff0000u);      \
        *(f32x4*)d = lo; *(f32x4*)(d + 4) = hi;                                                          \
      }                                                                                                  \
    }                                                                                                    \
    if (tid < 32) { sDT[tid] = predt; sDA[tid] = __expf(predt * Aneg); }                                 \
  }
  MB_ISSUE(0);
  MB_COMMIT();
  __syncthreads();
  float S[8];
#pragma unroll
  for (int i = 0; i < 8; ++i) S[i] = 0.f;
  for (int ci = 0; ci < 520; ++ci) {
    int rbase, t0, Ls; chunk_pos(ci, dir, rbase, t0, Ls);
    { const int e = tid * 2; const float dt = sDT[e >> 4]; sX[e] *= dt; sX[e + 1] *= dt; }
    LDS_BARRIER();
    if (ci + 1 < 520) MB_ISSUE(ci + 1);
    {
      const int pr = tid >> 4, part = tid & 15;
#define MB_LOAD(TT, B0, B1, C0, C1, XD, DA)                                                             \
      B0 = *(const f32x4*)(sB + (TT) * 128 + part * 4); B1 = *(const f32x4*)(sB + (TT) * 128 + 64 + part * 4); \
      C0 = *(const f32x4*)(sC + (TT) * 128 + part * 4); C1 = *(const f32x4*)(sC + (TT) * 128 + 64 + part * 4); \
      XD = sX[(TT) * 16 + pr]; DA = sDA[(TT)];
#define MB_SCAN(TTOF)                                                                                   \
      {                                                                                                 \
        f32x4 b0, b1, c0, c1; float xdt, da;                                                            \
        MB_LOAD(TTOF(0), b0, b1, c0, c1, xdt, da)                                                       \
        _Pragma("unroll") for (int s = 0; s < 32; ++s) {                                                \
          f32x4 nb0 = b0, nb1 = b1, nc0 = c0, nc1 = c1; float nxdt = xdt, nda = da;                     \
          if (s + 1 < 32) { MB_LOAD(TTOF(s + 1), nb0, nb1, nc0, nc1, nxdt, nda) }                       \
          float y = 0.f;                                                                                \
          _Pragma("unroll") for (int i = 0; i < 4; ++i) { S[i] = S[i] * da + xdt * b0[i]; y += S[i] * c0[i]; }             \
          _Pragma("unroll") for (int i = 0; i < 4; ++i) { S[4 + i] = S[4 + i] * da + xdt * b1[i]; y += S[4 + i] * c1[i]; } \
          sP[TTOF(s) * 256 + tid] = y;                                                                  \
          b0 = nb0; b1 = nb1; c0 = nc0; c1 = nc1; xdt = nxdt; da = nda;                                 \
        }                                                                                               \
      }
      if (dir) MB_SCAN(TT_BWD) else MB_SCAN(TT_FWD)
#undef MB_LOAD
#undef MB_SCAN
    }
    LDS_BARRIER();
    for (int e = tid; e < 512; e += 256) {
      const int tt = e >> 4, pr = e & 15;
      const float* pp = sP + tt * 256 + pr * 16;
      const f32x4 p0 = *(const f32x4*)pp, p1 = *(const f32x4*)(pp + 4), p2 = *(const f32x4*)(pp + 8), p3 = *(const f32x4*)(pp + 12);
      const float ys = ((p0[0] + p0[1]) + (p0[2] + p0[3])) + ((p1[0] + p1[1]) + (p1[2] + p1[3])) + ((p2[0] + p2[1]) + (p2[2] + p2[3])) + ((p3[0] + p3[1]) + (p3[2] + p3[3]));
      ydir[(size_t)(rbase + t0 + tt) * 1024 + head * 64 + qr * 16 + pr] = f2bf(ys);
    }
    if (ci + 1 < 520) MB_COMMIT();
    LDS_BARRIER();
  }
#undef MB_ISSUE
#undef MB_COMMIT
}

__device__ __forceinline__ void mamba_post(const P& p_unused, int j) {
  const P& p = params();
  const int tid_ = ltid(); const int lane = tid_ & 63, wv = tid_ >> 6;
  bf16_t* Z = (bf16_t*)(p.ws + OFF_U);
  const bf16_t* XBC = (const bf16_t*)(p.ws + OFF_U) + (E_ELEMS * 13) / 4;
  const bf16_t* yf = (const bf16_t*)(p.ws + OFF_R);
  const bf16_t* yb = yf + E_ELEMS;
  const float* cw = p.mb_conv_w + (size_t)j * 5 * 1536;
  const float* cb = p.mb_conv_b + j * 1536;
  const float* nw = p.mb_norm_w + j * 1024;
  for (int row = lbid() * 4 + wv; row < MT; row += gridDim.x * 4) {
    const int t = row < TL ? row : row - TL; const int Ls = row < TL ? TL : TC;
    float y[4][4]; float ssg[2] = {0.f, 0.f};
#pragma unroll
    for (int i = 0; i < 4; ++i) {
      const int c = i * 256 + lane * 4;
      const u32x2 xv = *(const u32x2*)(XBC + (size_t)row * 1536 + c);
      const float a0 = __uint_as_float(xv[0] << 16), a1 = __uint_as_float(xv[0] & 0xffff0000u), a2 = __uint_as_float(xv[1] << 16), a3 = __uint_as_float(xv[1] & 0xffff0000u);
      const float dsk = p.mb_d[j * 16 + (c >> 6)];
      const u32x2 f = *(const u32x2*)(yf + (size_t)row * 1024 + c), b = *(const u32x2*)(yb + (size_t)row * 1024 + c), z = *(const u32x2*)(Z + (size_t)row * 1024 + c);
      float v0 = __uint_as_float(f[0] << 16) + __uint_as_float(b[0] << 16) + dsk * a0;
      float v1 = __uint_as_float(f[0] & 0xffff0000u) + __uint_as_float(b[0] & 0xffff0000u) + dsk * a1;
      float v2 = __uint_as_float(f[1] << 16) + __uint_as_float(b[1] << 16) + dsk * a2;
      float v3 = __uint_as_float(f[1] & 0xffff0000u) + __uint_as_float(b[1] & 0xffff0000u) + dsk * a3;
      v0 *= silu_f(__uint_as_float(z[0] << 16)); v1 *= silu_f(__uint_as_float(z[0] & 0xffff0000u));
      v2 *= silu_f(__uint_as_float(z[1] << 16)); v3 *= silu_f(__uint_as_float(z[1] & 0xffff0000u));
      y[i][0] = v0; y[i][1] = v1; y[i][2] = v2; y[i][3] = v3;
      ssg[i >> 1] += v0 * v0 + v1 * v1 + v2 * v2 + v3 * v3;
    }
    const float s0 = wave_sum(ssg[0]), s1 = wave_sum(ssg[1]);
    const float r0 = rsqrtf(s0 * (1.f / 512.f) + 1e-6f), r1 = rsqrtf(s1 * (1.f / 512.f) + 1e-6f);
#pragma unroll
    for (int i = 0; i < 4; ++i) {
      const int c = i * 256 + lane * 4;
      const float rs = (i < 2) ? r0 : r1;
      const f32x4 w = *(const f32x4*)(nw + c);
      u32x2 o; o[0] = pack2(y[i][0] * rs * w[0], y[i][1] * rs * w[1]); o[1] = pack2(y[i][2] * rs * w[2], y[i][3] * rs * w[3]);
      *(u32x2*)(Z + (size_t)row * 1024 + c) = o;
    }
  }
}

__device__ __forceinline__ void ml_prep(const P& p_unused, int j) {
  const P& p = params();
  const int tid = ltid(), lane = tid & 63, wv = tid >> 6, bid = lbid();
  const float* fs = (const float*)(p.ws + OFF_FSIDE);
  f32x4* gates = (f32x4*)(p.ws + OFF_BONUS);
  if (bid < 2) {
    const int chain = bid * 4 + wv, dir = chain >> 2, head = chain & 3;
    const float ib = p.ml_i_bias[(j * 2 + dir) * 4 + head];
    const float fb = p.ml_f_bias[(j * 2 + dir) * 4 + head];
    float m_in = 0.f;
    float nf, ni;
    { const int row0 = TL + (dir ? TC - 1 - lane : lane); nf = fs[(size_t)row0 * 16 + 8 + dir * 4 + head]; ni = fs[(size_t)row0 * 16 + dir * 4 + head]; }
    for (int blk = 0; blk < 260; ++blk) {
      const bool isc = blk < 4;
      const int tb = isc ? blk : blk - 4, Ls = isc ? TC : TL, rbase = isc ? TL : 0;
      const int tpos = tb * 64 + lane;
      const int row = rbase + (dir ? Ls - 1 - tpos : tpos);
      const float rawf = nf, rawi = ni;
      if (blk + 1 < 260) {
        const int b2 = blk + 1; const bool isc2 = b2 < 4;
        const int tb2 = isc2 ? b2 : b2 - 4, Ls2 = isc2 ? TC : TL, rbase2 = isc2 ? TL : 0;
        const int tp2 = tb2 * 64 + lane;
        const float* f2 = fs + (size_t)(rbase2 + (dir ? Ls2 - 1 - tp2 : tp2)) * 16;
        nf = f2[8 + dir * 4 + head]; ni = f2[dir * 4 + head];
      }
      const float xf = rawf + fb;
      const float lf = fminf(xf, 0.f) - log1pf(__expf(-fabsf(xf)));
      const float ig = rawi + ib;
      float a = lf, b = ig;
#pragma unroll
      for (int off = 1; off < 64; off <<= 1) {
        const float a2 = __shfl_up(a, off), b2 = __shfl_up(b, off);
        if (lane >= off) { b = fmaxf(b2 + a, b); a = a2 + a; }
      }
      const float m = fmaxf(m_in + a, b);
      float mp = __shfl_up(m, 1);
      if (lane == 0) mp = m_in;
      gates[(size_t)chain * MT + row] = (f32x4){lf + mp - m, ig - m, __expf(-m), 0.f};
      m_in = __shfl(m, 63);
    }
  }
  const bf16_t* QK = (const bf16_t*)(p.ws + OFF_U) + E_ELEMS;
  bf16_t* QKC = (bf16_t*)(p.ws + OFF_R);
  const float* cw = p.ml_conv_w + (size_t)j * 5 * 2048;
  const float* cb = p.ml_conv_b + j * 2048;
  for (int it = bid * 256 + tid; it < (MT / 4) * 256; it += gridDim.x * 256) {
    const int vc = it & 255, r0 = (it >> 8) * 4, c = vc * 8;
    const int t0 = r0 < TL ? r0 : r0 - TL, Ls = r0 < TL ? TL : TC;
    float w[5][8], bias[8];
#pragma unroll
    for (int q = 0; q < 5; ++q) {
      const f32x4 wa = *(const f32x4*)(cw + q * 2048 + c), wb = *(const f32x4*)(cw + q * 2048 + c + 4);
      w[q][0] = wa[0]; w[q][1] = wa[1]; w[q][2] = wa[2]; w[q][3] = wa[3]; w[q][4] = wb[0]; w[q][5] = wb[1]; w[q][6] = wb[2]; w[q][7] = wb[3];
    }
    { const f32x4 ba = *(const f32x4*)(cb + c), bb = *(const f32x4*)(cb + c + 4);
      bias[0] = ba[0]; bias[1] = ba[1]; bias[2] = ba[2]; bias[3] = ba[3]; bias[4] = bb[0]; bias[5] = bb[1]; bias[6] = bb[2]; bias[7] = bb[3]; }
    u32x4 x[8];
#pragma unroll
    for (int r = 0; r < 8; ++r) {
      const int t = t0 - 2 + r;
      x[r] = (u32x4){0u, 0u, 0u, 0u};
      if (t >= 0 && t < Ls) x[r] = *(const u32x4*)(QK + (size_t)(r0 - 2 + r) * 2048 + c);
    }
    const float sc = (c < 1024) ? 0.0625f : 1.f;
#pragma unroll
    for (int o = 0; o < 4; ++o) {
      float a[8];
#pragma unroll
      for (int e = 0; e < 8; ++e) a[e] = bias[e];
#pragma unroll
      for (int q = 0; q < 5; ++q)
#pragma unroll
        for (int e = 0; e < 4; ++e) {
          a[2 * e] += w[q][2 * e] * __uint_as_float(x[o + q][e] << 16);
          a[2 * e + 1] += w[q][2 * e + 1] * __uint_as_float(x[o + q][e] & 0xffff0000u);
        }
      u32x4 ov;
#pragma unroll
      for (int e = 0; e < 4; ++e) ov[e] = pack2(silu_f(a[2 * e]) * sc, silu_f(a[2 * e + 1]) * sc);
      *(u32x4*)(QKC + (size_t)(r0 + o) * 2048 + c) = ov;
    }
  }
}

__device__ __forceinline__ void mlstm_scan(const P& p_unused, int j, char* smem, int bid) {
  const P& p = params();
  const int tid = ltid(), lane = tid & 63, wv = tid >> 6, fr = lane & 15, fq = lane >> 4;
  const int dir = bid >> 7, head = (bid >> 5) & 3, sl = bid & 31;
  bf16_t* sQb = (bf16_t*)smem;
  bf16_t* sKb = sQb + 32 * 264;
  bf16_t* sKT = sKb + 32 * 264;
  bf16_t* sVT = sKT + 256 * 40;
  bf16_t* sCb = sVT + 16 * 40;
  float* sI = (float*)(sCb + 16 * 264);
  float* sN = sI + 512;
  float* sCS = sN + 512;
  float* sLU = sCS + 32;
  float* sEM = sLU + 32;
  f32x4* sGt = (f32x4*)(sEM + 32);
  const bf16_t* QKC = (const bf16_t*)(p.ws + OFF_R);
  const bf16_t* V = (const bf16_t*)(p.ws + OFF_U) + 3 * E_ELEMS;
  const f32x4* gates = (const f32x4*)(p.ws + OFF_BONUS) + (size_t)(dir * 4 + head) * MT;
  bf16_t* hdir = (bf16_t*)(p.ws + OFF_U) + E_ELEMS + (size_t)dir * E_ELEMS;
  for (int e = tid; e < 16 * 40; e += 256) sVT[e] = 0;
  u32x4 preA[8], preB[8]; u32x4 prevA = {0u, 0u, 0u, 0u}, prevB = {0u, 0u, 0u, 0u}; f32x4 pregA = {0.f, 0.f, 0.f, 0.f}, pregB = {0.f, 0.f, 0.f, 0.f};
#define ML_ISSUE(CI, pre, prev, preg)                                                                                     \
  {                                                                                                      \
    int rb_, t0_, Ls_; chunk_pos((CI), dir, rb_, t0_, Ls_); (void)Ls_;                                   \
    _Pragma("unroll") for (int i = 0; i < 8; ++i) {                                                      \
      const int idx = tid + 256 * i, tt = idx >> 6, v = idx & 63;                                        \
      const int gc = (v < 32) ? head * 256 + v * 8 : 1024 + head * 256 + (v - 32) * 8;                   \
      pre[i] = *(const u32x4*)(QKC + (size_t)(rb_ + t0_ + tt) * 2048 + gc);                              \
    }                                                                                                    \
    if (tid < 32) {                                                                                      \
      prev = *(const u32x4*)(V + (size_t)(rb_ + t0_ + tid) * 1024 + head * 256 + sl * 8);                \
      preg = gates[rb_ + t0_ + tid];                                                                     \
    }                                                                                                    \
  }
#define ML_COMMIT(pre, prev, preg)                                                                                      \
  {                                                                                                      \
    _Pragma("unroll") for (int i = 0; i < 8; ++i) {                                                      \
      const int idx = tid + 256 * i, tt = idx >> 6, v = idx & 63;                                        \
      const int lr = dir ? 31 - tt : tt;                                                                 \
      if (v < 32) *(u32x4*)(sQb + lr * 264 + v * 8) = pre[i];                                            \
      else *(u32x4*)(sKb + lr * 264 + (v - 32) * 8) = pre[i];                                            \
    }                                                                                                    \
    if (tid < 32) {                                                                                      \
      const int lr = dir ? 31 - tid : tid;                                                               \
      sGt[lr] = preg;                                                                                    \
      _Pragma("unroll") for (int e = 0; e < 4; ++e) {                                                    \
        sVT[(2 * e) * 40 + lr] = (bf16_t)(prev[e] & 0xffffu); sVT[(2 * e + 1) * 40 + lr] = (bf16_t)(prev[e] >> 16); } \
      sVT[8 * 40 + lr] = (bf16_t)0x3F80;                                                                 \
    }                                                                                                    \
  }
  __syncthreads();
  ML_ISSUE(0, preA, prevA, pregA);
  ML_ISSUE(1, preB, prevB, pregB);
  ML_COMMIT(preA, prevA, pregA);
  LDS_BARRIER();
  f32x4 acc[4];
#pragma unroll
  for (int i = 0; i < 4; ++i) acc[i] = (f32x4){0.f, 0.f, 0.f, 0.f};
  for (int c2 = 0; c2 < 520; c2 += 2) {
#pragma unroll
    for (int half = 0; half < 2; ++half) {
    const int ci = c2 + half;
    int rbase, t0, Ls; chunk_pos(ci, dir, rbase, t0, Ls); (void)Ls;
    if (half == 0) { if (ci + 2 < 520) ML_ISSUE(ci + 2, preA, prevA, pregA); }
    else { if (ci + 2 < 520) ML_ISSUE(ci + 2, preB, prevB, pregB); }
    if (wv == 0) {
      const int l5 = lane & 31;
      const f32x4 g = sGt[l5];
      float x = g[0];
#pragma unroll
      for (int off = 1; off < 32; off <<= 1) { const float y = __shfl_up(x, off); if (l5 >= off) x += y; }
      if (lane < 32) { sCS[lane] = x; sLU[lane] = g[1] - x; sEM[lane] = g[2]; }
    }
#pragma unroll
    for (int i = 0; i < 4; ++i)
#pragma unroll
      for (int jj = 0; jj < 4; ++jj) sCb[(fq * 4 + jj) * 264 + (wv * 4 + i) * 16 + fr] = f2bf(acc[i][jj]);
    LDS_BARRIER();
    if (wv < 2) {
      const int st = wv;
      f32x4 sa[2];
      sa[0] = (f32x4){0.f, 0.f, 0.f, 0.f}; sa[1] = sa[0];
#pragma unroll
      for (int ks = 0; ks < 8; ++ks) {
        const bf16x8 qf = *(const bf16x8*)(sQb + (st * 16 + fr) * 264 + ks * 32 + fq * 8);
#pragma unroll
        for (int ut = 0; ut < 2; ++ut) {
          const bf16x8 kf = *(const bf16x8*)(sKb + (ut * 16 + fr) * 264 + ks * 32 + fq * 8);
          sa[ut] = __builtin_amdgcn_mfma_f32_16x16x32_bf16(kf, qf, sa[ut], 0, 0, 0);
        }
      }
      const int s = st * 16 + fr;
      const float css = sCS[s];
      float e[8];
#pragma unroll
      for (int ut = 0; ut < 2; ++ut)
#pragma unroll
        for (int jj = 0; jj < 4; ++jj) {
          const int u = ut * 16 + fq * 4 + jj;
          e[ut * 4 + jj] = (u <= s) ? sa[ut][jj] * __expf(css + sLU[u]) : 0.f;
        }
      u32x4 pk; pk[0] = pack2(e[0], e[1]); pk[1] = pack2(e[2], e[3]); pk[2] = pack2(e[4], e[5]); pk[3] = pack2(e[6], e[7]);
      const u32x2 v0 = *(const u32x2*)(sVT + fr * 40 + fq * 4), v1 = *(const u32x2*)(sVT + fr * 40 + 16 + fq * 4);
      u32x4 vv; vv[0] = v0[0]; vv[1] = v0[1]; vv[2] = v1[0]; vv[3] = v1[1];
      f32x4 o = {0.f, 0.f, 0.f, 0.f};
      o = __builtin_amdgcn_mfma_f32_16x16x32_bf16(__builtin_bit_cast(bf16x8, vv), __builtin_bit_cast(bf16x8, pk), o, 0, 0, 0);
#pragma unroll
      for (int jj = 0; jj < 4; ++jj) sN[(fq * 4 + jj) * 32 + s] = o[jj];
    } else {
      const int st = wv - 2;
      f32x4 ia = {0.f, 0.f, 0.f, 0.f};
#pragma unroll
      for (int ks = 0; ks < 8; ++ks) {
        const bf16x8 cf = *(const bf16x8*)(sCb + fr * 264 + ks * 32 + fq * 8);
        const bf16x8 qf = *(const bf16x8*)(sQb + (st * 16 + fr) * 264 + ks * 32 + fq * 8);
        ia = __builtin_amdgcn_mfma_f32_16x16x32_bf16(cf, qf, ia, 0, 0, 0);
      }
      const int s = st * 16 + fr;
      const float wg = __expf(sCS[s]);
#pragma unroll
      for (int jj = 0; jj < 4; ++jj) sI[(fq * 4 + jj) * 32 + s] = ia[jj] * wg;
    }
    LDS_BARRIER();
    {
      const int s = tid >> 3, v = tid & 7;
      const float num = sN[v * 32 + s] + sI[v * 32 + s];
      const float den = sN[8 * 32 + s] + sI[8 * 32 + s];
      const float h = num * __builtin_amdgcn_rcpf(fmaxf(fabsf(den), sEM[s]));
      const int tt = dir ? 31 - s : s;
      hdir[(size_t)(rbase + t0 + tt) * 1024 + head * 256 + sl * 8 + v] = f2bf(h);
    }
    {
      const float cs31 = sCS[31];
      const float keep = __expf(cs31);
      const u32x4 vr = *(const u32x4*)(sVT + fr * 40 + fq * 8);
      const f32x4 lu0 = *(const f32x4*)(sLU + fq * 8), lu1 = *(const f32x4*)(sLU + fq * 8 + 4);
      u32x4 aw;
      aw[0] = pack2(__uint_as_float(vr[0] << 16) * __expf(cs31 + lu0[0]), __uint_as_float(vr[0] & 0xffff0000u) * __expf(cs31 + lu0[1]));
      aw[1] = pack2(__uint_as_float(vr[1] << 16) * __expf(cs31 + lu0[2]), __uint_as_float(vr[1] & 0xffff0000u) * __expf(cs31 + lu0[3]));
      aw[2] = pack2(__uint_as_float(vr[2] << 16) * __expf(cs31 + lu1[0]), __uint_as_float(vr[2] & 0xffff0000u) * __expf(cs31 + lu1[1]));
      aw[3] = pack2(__uint_as_float(vr[3] << 16) * __expf(cs31 + lu1[2]), __uint_as_float(vr[3] & 0xffff0000u) * __expf(cs31 + lu1[3]));
      const bf16x8 af = __builtin_bit_cast(bf16x8, aw);
#pragma unroll
      for (int i = 0; i < 4; ++i) {
        const bf16_t* kc = sKb + (fq * 8) * 264 + (wv * 4 + i) * 16 + fr;
        u32x4 kw;
        kw[0] = (unsigned)kc[0] | ((unsigned)kc[264] << 16); kw[1] = (unsigned)kc[2 * 264] | ((unsigned)kc[3 * 264] << 16);
        kw[2] = (unsigned)kc[4 * 264] | ((unsigned)kc[5 * 264] << 16); kw[3] = (unsigned)kc[6 * 264] | ((unsigned)kc[7 * 264] << 16);
        acc[i] = __builtin_amdgcn_mfma_f32_16x16x32_bf16(af, __builtin_bit_cast(bf16x8, kw), acc[i] * keep, 0, 0, 0);
      }
    }
    LDS_BARRIER();
    if (half == 0) { ML_COMMIT(preB, prevB, pregB); }
    else { if (ci + 1 < 520) ML_COMMIT(preA, prevA, pregA); }
    LDS_BARRIER();
    }
  }
#undef ML_ISSUE
#undef ML_COMMIT
}

__device__ __forceinline__ void mlstm_post(const P& p_unused, int j) {
  const P& p = params();
  const int tid_ = ltid(); const int lane = tid_ & 63, wv = tid_ >> 6;
  bf16_t* Z = (bf16_t*)(p.ws + OFF_U);
  const bf16_t* O = (const bf16_t*)(p.ws + OFF_U) + 4 * E_ELEMS;
  const bf16_t* hf = (const bf16_t*)(p.ws + OFF_U) + E_ELEMS;
  const bf16_t* hb = hf + E_ELEMS;
  const int c0 = lane * 16;
  float nw[16];
#pragma unroll
  for (int i = 0; i < 16; ++i) nw[i] = p.ml_norm_w[j * 1024 + c0 + i];
  for (int row = lbid() * 4 + wv; row < MT; row += gridDim.x * 4) {
    const size_t off = (size_t)row * 1024 + c0;
    float a[16], b2[16], o[16], z[16];
    unpack8(*(const u32x4*)(hf + off), a); unpack8(*(const u32x4*)(hf + off + 8), a + 8);
    unpack8(*(const u32x4*)(hb + off), b2); unpack8(*(const u32x4*)(hb + off + 8), b2 + 8);
    unpack8(*(const u32x4*)(O + off), o); unpack8(*(const u32x4*)(O + off + 8), o + 8);
    unpack8(*(const u32x4*)(Z + off), z); unpack8(*(const u32x4*)(Z + off + 8), z + 8);
    float ss = 0.f;
#pragma unroll
    for (int i = 0; i < 16; ++i) { a[i] += b2[i]; ss += a[i] * a[i]; }
    ss = sum16(ss);
    const float rs = rsqrtf(ss * (1.f / 256.f) + 1e-6f);
    float r[16];
#pragma unroll
    for (int i = 0; i < 16; ++i) r[i] = a[i] * rs * nw[i] * sigmoid_f(o[i]) * silu_f(z[i]);
    u32x4 w0, w1;
    w0[0] = pack2(r[0], r[1]); w0[1] = pack2(r[2], r[3]); w0[2] = pack2(r[4], r[5]); w0[3] = pack2(r[6], r[7]);
    w1[0] = pack2(r[8], r[9]); w1[1] = pack2(r[10], r[11]); w1[2] = pack2(r[12], r[13]); w1[3] = pack2(r[14], r[15]);
    *(u32x4*)(Z + off) = w0; *(u32x4*)(Z + off + 8) = w1;
  }
}

__device__ __forceinline__ void attn_prep(const P& p_unused, int j, char* smem) {
  const P& p = params();
  const int tid = ltid();
  bf16_t* Q = (bf16_t*)(p.ws + OFF_U) + 2 * E_ELEMS;
  bf16_t* KV = (bf16_t*)(p.ws + OFF_U) + 3 * E_ELEMS;
  bf16_t* VT = KV + E_ELEMS / 2;
  const float* qn = p.at_q_norm + j * 64;
  const float* kn = p.at_k_norm + j * 64;
  const int total = MT * 20;
  for (int idx = lbid() * 256 + tid; idx < total; idx += gridDim.x * 256) {
    const int t = idx / 20, u = idx - t * 20;
    bf16_t* ptr; const float* w; float scale;
    if (u < 16) { ptr = Q + (size_t)t * 1024 + u * 64; w = qn; scale = 0.125f * 1.4426950408889634f; }
    else { ptr = KV + (size_t)t * 512 + (u - 16) * 64; w = kn; scale = 1.f; }
    float x[64]; float ss = 0.f;
#pragma unroll
    for (int i = 0; i < 8; ++i) {
      const u32x4 v = *(const u32x4*)(ptr + i * 8);
#pragma unroll
      for (int e = 0; e < 4; ++e) {
        x[i * 8 + 2 * e] = __uint_as_float(v[e] << 16);
        x[i * 8 + 2 * e + 1] = __uint_as_float(v[e] & 0xffff0000u);
      }
    }
#pragma unroll
    for (int i = 0; i < 64; ++i) ss += x[i] * x[i];
    const float rs = rsqrtf(ss * (1.f / 64.f) + 1e-6f);
#pragma unroll
    for (int i = 0; i < 64; ++i) x[i] = x[i] * rs * w[i];
    if (t < TL) {
      const float rowi = (float)(t >> 6), coli = (float)(t & 63);
#pragma unroll
      for (int i = 0; i < 16; ++i) {
        const float inv = exp2f(-(float)i * (13.287712379549449f / 16.f));
        float tr = rowi * inv * 0.15915494309189535f; tr -= floorf(tr);
        float tc = coli * inv * 0.15915494309189535f; tc -= floorf(tc);
        const float cr = __builtin_amdgcn_cosf(tr), sr = __builtin_amdgcn_sinf(tr);
        const float cc = __builtin_amdgcn_cosf(tc), sc = __builtin_amdgcn_sinf(tc);
        const float a1 = x[i], a2 = x[i + 16];
        x[i] = a1 * cr - a2 * sr; x[i + 16] = a1 * sr + a2 * cr;
        const float b1 = x[32 + i], b2 = x[48 + i];
        x[32 + i] = b1 * cc - b2 * sc; x[48 + i] = b1 * sc + b2 * cc;
      }
    }
#pragma unroll
    for (int i = 0; i < 8; ++i) {
      u32x4 v;
#pragma unroll
      for (int e = 0; e < 4; ++e) v[e] = pack2(x[i * 8 + 2 * e] * scale, x[i * 8 + 2 * e + 1] * scale);
      *(u32x4*)(ptr + i * 8) = v;
    }
  }
  bf16_t* sT = (bf16_t*)smem;
  for (int it = lbid(); it < 260 * 4; it += gridDim.x) {
    const int tb = (it >> 2) * 64, cbk = (it & 3) * 64;
    {
      const int tt = tid >> 2, cq = (tid & 3) * 16;
      const bf16_t* s = KV + (size_t)(tb + tt) * 512 + 256 + cbk + cq;
      const u32x4 v0 = *(const u32x4*)s, v1 = *(const u32x4*)(s + 8);
#pragma unroll
      for (int e = 0; e < 4; ++e) {
        sT[(cq + 2 * e) * 72 + tt] = (bf16_t)(v0[e] & 0xffffu); sT[(cq + 2 * e + 1) * 72 + tt] = (bf16_t)(v0[e] >> 16);
        sT[(cq + 8 + 2 * e) * 72 + tt] = (bf16_t)(v1[e] & 0xffffu); sT[(cq + 8 + 2 * e + 1) * 72 + tt] = (bf16_t)(v1[e] >> 16);
      }
    }
    __syncthreads();
    {
      const int c = tid >> 2, tq = (tid & 3) * 16;
      const u32x4 v0 = *(const u32x4*)(sT + c * 72 + tq), v1 = *(const u32x4*)(sT + c * 72 + tq + 8);
      bf16_t* d = VT + (size_t)(cbk + c) * MT + tb + tq;
      *(u32x4*)d = v0; *(u32x4*)(d + 8) = v1;
    }
    __syncthreads();
  }
}

__device__ __forceinline__ void attn_phase(const P& p_unused, int j, char* smem) {
  const P& p = params();
  const int tid = ltid(), lane = tid & 63, wv = tid >> 6, fr = lane & 15, fq = lane >> 4;
  bf16_t* G = (bf16_t*)(p.ws + OFF_U) + E_ELEMS;
  const bf16_t* Q = (const bf16_t*)(p.ws + OFF_U) + 2 * E_ELEMS;
  const bf16_t* KV = (const bf16_t*)(p.ws + OFF_U) + 3 * E_ELEMS;
  const bf16_t* VT = KV + E_ELEMS / 2;
  bf16_t* sK = (bf16_t*)smem;
  bf16_t* sV = sK + 2 * 64 * 72;
  float gq = 0.f, gk = 0.f;
  for (int i = 0; i < 64; ++i) { gq = fmaxf(gq, fabsf(p.at_q_norm[j * 64 + i])); gk = fmaxf(gk, fabsf(p.at_k_norm[j * 64 + i])); }
  const float nshift = -(8.f * gq * gk * 1.4426950408889634f);
  for (int item = lbid(); item < ((j == 1) ? 1024 : 1024 + 16); item += gridDim.x) {
    int head, q0, kv0, nkt;
    if (item < 1024) { head = item & 15; q0 = (item >> 4) * 256; kv0 = 0; nkt = 260; }
    else { head = item - 1024; q0 = TL; kv0 = TL; nkt = 4; }
    const int kvh = head >> 2;
    bf16x8 qf[4][2];
#pragma unroll
    for (int qt = 0; qt < 4; ++qt)
#pragma unroll
      for (int ks = 0; ks < 2; ++ks)
        qf[qt][ks] = *(const bf16x8*)(Q + (size_t)(q0 + wv * 64 + qt * 16 + fr) * 1024 + head * 64 + ks * 32 + fq * 8);
    f32x4 o[4][4]; float ls[4];
#pragma unroll
    for (int a = 0; a < 4; ++a) { ls[a] = 0.f;
#pragma unroll
      for (int b = 0; b < 4; ++b) o[a][b] = (f32x4){0.f, 0.f, 0.f, 0.f}; }
    u32x4 rk[2], rv[2];
#pragma unroll
    for (int i = 0; i < 2; ++i) {
      const int id = tid + 256 * i, r = id >> 3, ch = (id & 7) * 8;
      rk[i] = *(const u32x4*)(KV + (size_t)(kv0 + r) * 512 + kvh * 64 + ch);
      rv[i] = *(const u32x4*)(VT + (size_t)(kvh * 64 + r) * MT + kv0 + ch);
    }
#pragma unroll
    for (int i = 0; i < 2; ++i) {
      const int id = tid + 256 * i, r = id >> 3, ch = (id & 7) * 8;
      *(u32x4*)(sK + r * 72 + ch) = rk[i];
      *(u32x4*)(sV + r * 72 + ch) = rv[i];
    }
    __syncthreads();
    for (int kt = 0; kt < nkt; ++kt) {
      const bf16_t* bK = sK + (kt & 1) * 64 * 72;
      const bf16_t* bV = sV + (kt & 1) * 64 * 72;
      if (kt + 1 < nkt) {
#pragma unroll
        for (int i = 0; i < 2; ++i) {
          const int id = tid + 256 * i, r = id >> 3, ch = (id & 7) * 8;
          rk[i] = *(const u32x4*)(KV + (size_t)(kv0 + (kt + 1) * 64 + r) * 512 + kvh * 64 + ch);
          rv[i] = *(const u32x4*)(VT + (size_t)(kvh * 64 + r) * MT + kv0 + (kt + 1) * 64 + ch);
        }
      }
#pragma unroll 1
      for (int kk = 0; kk < 2; ++kk) {
        f32x4 s[2][4];
#pragma unroll
        for (int a = 0; a < 2; ++a)
#pragma unroll
          for (int b = 0; b < 4; ++b) s[a][b] = (f32x4){nshift, nshift, nshift, nshift};
#pragma unroll
        for (int a = 0; a < 2; ++a)
#pragma unroll
          for (int ks = 0; ks < 2; ++ks) {
            const bf16x8 kf = *(const bf16x8*)(bK + ((kk * 2 + a) * 16 + fr) * 72 + ks * 32 + fq * 8);
#pragma unroll
            for (int qt = 0; qt < 4; ++qt) s[a][qt] = __builtin_amdgcn_mfma_f32_16x16x32_bf16(kf, qf[qt][ks], s[a][qt], 0, 0, 0);
          }
        bf16x8 pb[4];
#pragma unroll
        for (int qt = 0; qt < 4; ++qt) {
          float e[8];
#pragma unroll
          for (int i = 0; i < 4; ++i) { e[i] = __builtin_amdgcn_exp2f(s[0][qt][i]); e[4 + i] = __builtin_amdgcn_exp2f(s[1][qt][i]); }
          ls[qt] += ((e[0] + e[1]) + (e[2] + e[3])) + ((e[4] + e[5]) + (e[6] + e[7]));
          u32x4 pk; pk[0] = pack2(e[0], e[1]); pk[1] = pack2(e[2], e[3]); pk[2] = pack2(e[4], e[5]); pk[3] = pack2(e[6], e[7]);
          pb[qt] = __builtin_bit_cast(bf16x8, pk);
        }
#pragma unroll
        for (int dt = 0; dt < 4; ++dt) {
          const u32x2 v0 = *(const u32x2*)(bV + (dt * 16 + fr) * 72 + kk * 32 + fq * 4);
          const u32x2 v1 = *(const u32x2*)(bV + (dt * 16 + fr) * 72 + kk * 32 + 16 + fq * 4);
          u32x4 vv; vv[0] = v0[0]; vv[1] = v0[1]; vv[2] = v1[0]; vv[3] = v1[1];
          const bf16x8 vf = __builtin_bit_cast(bf16x8, vv);
#pragma unroll
          for (int qt = 0; qt < 4; ++qt) o[dt][qt] = __builtin_amdgcn_mfma_f32_16x16x32_bf16(vf, pb[qt], o[dt][qt], 0, 0, 0);
        }
      }
      if (kt + 1 < nkt) {
        bf16_t* nK = sK + ((kt + 1) & 1) * 64 * 72;
        bf16_t* nV = sV + ((kt + 1) & 1) * 64 * 72;
#pragma unroll
        for (int i = 0; i < 2; ++i) {
          const int id = tid + 256 * i, r = id >> 3, ch = (id & 7) * 8;
          *(u32x4*)(nK + r * 72 + ch) = rk[i];
          *(u32x4*)(nV + r * 72 + ch) = rv[i];
        }
      }
      __syncthreads();
    }
#pragma unroll
    for (int qt = 0; qt < 4; ++qt) {
      float l = ls[qt];
      l += __shfl_xor(l, 16); l += __shfl_xor(l, 32);
      const float inv = 1.f / l;
      const int row = q0 + wv * 64 + qt * 16 + fr;
#pragma unroll
      for (int dt = 0; dt < 4; ++dt) {
        bf16_t* gp = G + (size_t)row * 1024 + head * 64 + dt * 16 + fq * 4;
        const u32x2 gv = *(const u32x2*)gp;
        const float g0 = __uint_as_float(gv[0] << 16), g1 = __uint_as_float(gv[0] & 0xffff0000u);
        const float g2 = __uint_as_float(gv[1] << 16), g3 = __uint_as_float(gv[1] & 0xffff0000u);
        u32x2 ov;
        ov[0] = pack2(o[dt][qt][0] * inv * silu_f(g0), o[dt][qt][1] * inv * silu_f(g1));
        ov[1] = pack2(o[dt][qt][2] * inv * silu_f(g2), o[dt][qt][3] * inv * silu_f(g3));
        *(u32x2*)gp = ov;
      }
    }
  }
}

__device__ __forceinline__ void final_norm(const P& p_unused) {
  const P& p = params();
  const int tid_ = ltid(); const int lane = tid_ & 63, wv = tid_ >> 6;
  for (int row = lbid() * 4 + wv; row < TL; row += gridDim.x * 4) {
    float* src = p.out + (size_t)row * 1024;
    f32x4 v[4]; float ss = 0.f;
#pragma unroll
    for (int i = 0; i < 4; ++i) { v[i] = *(const f32x4*)(src + i * 256 + lane * 4); ss += v[i][0] * v[i][0] + v[i][1] * v[i][1] + v[i][2] * v[i][2] + v[i][3] * v[i][3]; }
    ss = wave_sum(ss);
    const float rs = rsqrtf(ss * (1.f / 1024.f) + 1e-6f);
#pragma unroll
    for (int i = 0; i < 4; ++i) {
      const f32x4 g = *(const f32x4*)(p.norm_final + i * 256 + lane * 4);
      f32x4 o; o[0] = v[i][0] * rs * g[0]; o[1] = v[i][1] * rs * g[1]; o[2] = v[i][2] * rs * g[2]; o[3] = v[i][3] * rs * g[3];
      *(f32x4*)(src + i * 256 + lane * 4) = o;
    }
  }
}


__device__ __forceinline__ void grid_barrier(unsigned* bar, unsigned epoch) {
  __syncthreads();
  if (threadIdx.x == 0) {
    __threadfence();
    const unsigned ngroups = gridDim.x >> 5;
    const unsigned g = blockIdx.x >> 5;
    const unsigned old = __hip_atomic_fetch_add(bar + 64 * (2 + g), 1u, __ATOMIC_RELAXED, __HIP_MEMORY_SCOPE_AGENT);
    if (old == 32u * epoch - 1u) {
      const unsigned o2 = __hip_atomic_fetch_add(bar + 64, 1u, __ATOMIC_RELAXED, __HIP_MEMORY_SCOPE_AGENT);
      if (o2 == ngroups * epoch - 1u) __hip_atomic_store(bar, epoch, __ATOMIC_RELAXED, __HIP_MEMORY_SCOPE_AGENT);
    }
    while (__hip_atomic_load(bar, __ATOMIC_RELAXED, __HIP_MEMORY_SCOPE_AGENT) < epoch) __builtin_amdgcn_s_sleep(32);
    __threadfence();
  }
  __syncthreads();
}


__device__ __forceinline__ void ab_prep(const P& p_unused, int j, unsigned* bar, unsigned& epoch) {
  const P& p = params();
  const int tid = ltid(), bid = lbid();
  bf16_t* XBC = (bf16_t*)(p.ws + OFF_U) + (E_ELEMS * 13) / 4;
  bf16_t* URK = (bf16_t*)(p.ws + OFF_U) + E_ELEMS;
  const float* cw = p.mb_conv_w + (size_t)j * 5 * 1536;
  const float* cb = p.mb_conv_b + j * 1536;
  const float* mu = p.rk_mu + j * 1792;
  for (int ubase = 0; ubase < 260; ubase += gridDim.x) {
  const int unit = ubase + bid;
  const bool act = unit < 260;
  const int rbase = (unit < 256) ? 0 : TL, t0 = (unit < 256) ? unit * 64 : (unit - 256) * 64, Ls = (unit < 256) ? TL : TC;
  unsigned hm2[7], hm1[7], hp0[7], hp1[7];
#pragma unroll
  for (int k = 0; k < 7; ++k) {
    hm2[k] = 0u; hm1[k] = 0u; hp0[k] = 0u; hp1[k] = 0u;
    const int pi = tid + 256 * k;
    if (act && pi < 1664) {
      const bf16_t* base = (pi < 768) ? XBC + 2 * pi : URK + 2 * (pi - 768);
      const int ld = (pi < 768) ? 1536 : 2304;
      const bf16_t* r0 = base + (size_t)(rbase + t0) * ld;
      if (t0 - 2 >= 0) hm2[k] = *(const unsigned*)(r0 - 2 * ld);
      if (t0 - 1 >= 0) hm1[k] = *(const unsigned*)(r0 - ld);
      if (t0 + 64 < Ls) hp0[k] = *(const unsigned*)(r0 + 64 * ld);
      if (t0 + 65 < Ls) hp1[k] = *(const unsigned*)(r0 + 65 * ld);
    }
  }
  grid_barrier(bar, ++epoch);
  if (act) {
#pragma unroll
  for (int k = 0; k < 7; ++k) {
    const int pi = tid + 256 * k;
    if (pi >= 1664) continue;
    if (pi < 768) {
      const int c = 2 * pi;
      bf16_t* r0 = XBC + (size_t)(rbase + t0) * 1536 + c;
      float wa[5], wb[5];
#pragma unroll
      for (int q = 0; q < 5; ++q) { wa[q] = cw[q * 1536 + c]; wb[q] = cw[q * 1536 + c + 1]; }
      const float ba = cb[c], bb = cb[c + 1];
      unsigned w0 = hm2[k], w1 = hm1[k], w2 = *(const unsigned*)r0, w3 = *(const unsigned*)(r0 + 1536);
#pragma unroll
      for (int s0 = 0; s0 < 64; s0 += 16) {
        unsigned nx[16];
#pragma unroll
        for (int i = 0; i < 16; ++i) { const int t = s0 + i + 2; nx[i] = (t < 64) ? *(const unsigned*)(r0 + (size_t)t * 1536) : ((t == 64) ? hp0[k] : hp1[k]); }
#pragma unroll
        for (int i = 0; i < 16; ++i) {
          const unsigned w4 = nx[i];
          const float a0 = ba + wa[0] * __uint_as_float(w0 << 16) + wa[1] * __uint_as_float(w1 << 16) + wa[2] * __uint_as_float(w2 << 16) +
                           wa[3] * __uint_as_float(w3 << 16) + wa[4] * __uint_as_float(w4 << 16);
          const float a1 = bb + wb[0] * __uint_as_float(w0 & 0xffff0000u) + wb[1] * __uint_as_float(w1 & 0xffff0000u) + wb[2] * __uint_as_float(w2 & 0xffff0000u) +
                           wb[3] * __uint_as_float(w3 & 0xffff0000u) + wb[4] * __uint_as_float(w4 & 0xffff0000u);
          *(unsigned*)(r0 + (size_t)(s0 + i) * 1536) = pack2(silu_f(a0), silu_f(a1));
          w0 = w1; w1 = w2; w2 = w3; w3 = w4;
        }
      }
    } else {
      const int c = 2 * (pi - 768);
      bf16_t* r0 = URK + (size_t)(rbase + t0) * 2304 + c;
      const float m0 = mu[c], m1 = mu[c + 1];
      const bool is_wl = (c >= 1536) && (c < 1664);
      unsigned prev = hm1[k], cur = *(const unsigned*)r0;
#pragma unroll
      for (int s0 = 0; s0 < 64; s0 += 16) {
        unsigned nx[16];
#pragma unroll
        for (int i = 0; i < 16; ++i) { const int t = s0 + i + 1; nx[i] = (t < 64) ? *(const unsigned*)(r0 + (size_t)t * 2304) : hp0[k]; }
#pragma unroll
        for (int i = 0; i < 16; ++i) {
          const unsigned nxt = nx[i];
          const float c0 = __uint_as_float(cur << 16), c1 = __uint_as_float(cur & 0xffff0000u);
          float v0 = c0 + m0 * (0.5f * (__uint_as_float(prev << 16) + __uint_as_float(nxt << 16)) - c0);
          float v1 = c1 + m1 * (0.5f * (__uint_as_float(prev & 0xffff0000u) + __uint_as_float(nxt & 0xffff0000u)) - c1);
          if (is_wl) {
            const float e0 = __expf(2.f * v0), e1 = __expf(2.f * v1);
            v0 = 1.f - 2.f * __builtin_amdgcn_rcpf(e0 + 1.f); v1 = 1.f - 2.f * __builtin_amdgcn_rcpf(e1 + 1.f);
          }
          *(unsigned*)(r0 + (size_t)(s0 + i) * 2304) = pack2(v0, v1);
          prev = cur; cur = nxt;
        }
      }
    }
  }
  }
  }
}

__global__ void __launch_bounds__(256, 2) mega_fwd(P p) {
  extern __shared__ __attribute__((aligned(16))) char smem[];
  cg::grid_group grid = cg::this_grid();
  mods_phase(p, smem);
  grid.sync();
  unsigned epoch = 0;
    for (int step = 0; step < 40; ++step) {
    const int l = step / 10, idx = step - l * 10, j = l >> 1;
    const unsigned long long ops = (l & 1) ? 0x1981076A10ull : 0xFFFF1CBD10ull;
    const unsigned long long ags = (l & 1) ? 0x4003100020ull : 0x0000400000ull;
    const int op = (int)((ops >> (4 * idx)) & 15), arg = (int)((ags >> (4 * idx)) & 15);
    if (op == 15) continue;
    if (op == 0) { norm_phase(p, l); transposes_for_layer(p, l, arg, smem); }
    else if (op == 1) gemm_phase(p, arg, l, smem);
    else if (op == 6) { for (int b = lbid(); b < 256; b += gridDim.x) { mlstm_scan(p, j, smem, b); __syncthreads(); } }
    else if (op == 7) mlstm_post(p, j);
    else if (op == 8) attn_prep(p, j, smem);
    else if (op == 10) ml_prep(p, j);
    else if (op == 13) ab_prep(p, j, (unsigned*)(params().ws + OFF_BAR), epoch);
    else if (op == 11) { const int b = lbid(); if (b < 128) mamba_scan(p, j, smem, b); else if (b < 192) rwkv_scan(p, j, smem, b - 128); }
    else if (op == 12) { mamba_post(p, j); rwkv_post(p, j); }
    else attn_phase(p, j, smem);
    grid_barrier((unsigned*)(params().ws + OFF_BAR), ++epoch);
  }
  final_norm(p);
}

extern "C" void kernel_launch(void* const* d_in, const int* in_sizes, int n_in, void* d_out, int out_size, void* d_ws, size_t ws_size,
                              hipStream_t stream) {
  static int grid_blocks = 0;
  if (!grid_blocks) {
    int dev = 0, cus = 0, per_cu = 0;
    (void)hipGetDevice(&dev);
    (void)hipDeviceGetAttribute(&cus, hipDeviceAttributeMultiprocessorCount, dev);
    (void)hipFuncSetAttribute((const void*)mega_fwd, hipFuncAttributeMaxDynamicSharedMemorySize, LDS_BYTES);
    (void)hipOccupancyMaxActiveBlocksPerMultiprocessor(&per_cu, mega_fwd, 256, LDS_BYTES);
    if (per_cu > 2) per_cu = 2;
    if (per_cu < 1) per_cu = 1;
    grid_blocks = cus * per_cu;
  }
  P p{};
  const float** pf = (const float**)&p;
  for (int i = 0; i < 35; ++i) pf[i] = (const float*)d_in[i];
  p.out = (float*)d_out;
  p.ws = (unsigned char*)d_ws;
  (void)hipMemsetAsync((unsigned char*)d_ws + OFF_BAR, 0, 64 * 4 * 32, stream);
  void* args[] = {&p};
  hipError_t e = hipLaunchCooperativeKernel((void*)mega_fwd, dim3(grid_blocks), dim3(256), args, LDS_BYTES, stream);
  if (e != hipSuccess) fprintf(stderr, "cooperative launch failed: %s (grid %d)\n", hipGetErrorString(e), grid_blocks);
}
```

```cpp
#include <hip/hip_runtime.h>
#include <hip/hip_cooperative_groups.h>
#include <cstdio>
#include <cstdint>
namespace cg = cooperative_groups;

#define TL 16384
#define TC 256
#define MT 16640
typedef unsigned short bf16_t;
typedef short bf16x8 __attribute__((ext_vector_type(8)));
typedef float f32x4 __attribute__((ext_vector_type(4)));
typedef unsigned u32x4 __attribute__((ext_vector_type(4)));
typedef unsigned u32x2 __attribute__((ext_vector_type(2)));

#define E_ELEMS ((size_t)MT * 1024)
#define OFF_CTXS 0u
#define OFF_MODS 1048576u
#define OFF_BONUS 1146880u
#define OFF_FSIDE 3276800u
#define OFF_WO 5406720u
#define OFF_R 9601024u
#define OFF_U 77758464u
#define LDS_BYTES 73728
#define OFF_BAR 260046848u

struct P {
  const float *x, *c, *ctx, *c_ctx, *norm_g, *ada_w, *ada_b, *norm_final, *ab_w_in, *ab_w_out;
  const float *rk_mu, *rk_w0, *rk_w2, *rk_a0, *rk_a2, *rk_k_k, *rk_k_a, *rk_r_k, *rk_ln_w, *rk_ln_b;
  const float *mb_conv_w, *mb_conv_b, *mb_dt_bias, *mb_a_log, *mb_d, *mb_norm_w, *cd_w_in, *cd_w_out;
  const float *ml_conv_w, *ml_conv_b, *ml_i_bias, *ml_f_bias, *ml_norm_w, *at_q_norm, *at_k_norm;
  float* out;
  unsigned char* ws;
};


__device__ __forceinline__ const P& params() {
  auto kp = __builtin_amdgcn_kernarg_segment_ptr();
  asm volatile("" : "+s"(kp));
  return *(const P*)kp;
}

__device__ __forceinline__ int ltid() { int t = threadIdx.x; asm volatile("" : "+v"(t)); return t; }
__device__ __forceinline__ int lbid() { int b = blockIdx.x; asm volatile("" : "+s"(b)); return b; }

__device__ __forceinline__ float bf2f(bf16_t h) { return __uint_as_float(((unsigned)h) << 16); }
typedef __bf16 bf16x2_t __attribute__((ext_vector_type(2)));
typedef float f32x2_t __attribute__((ext_vector_type(2)));
__device__ __forceinline__ unsigned pack2(float lo, float hi) { const f32x2_t v = {lo, hi}; const bf16x2_t b = __builtin_convertvector(v, bf16x2_t); return __builtin_bit_cast(unsigned, b); }
__device__ __forceinline__ bf16_t f2bf(float f) { return (bf16_t)(pack2(f, 0.f) & 0xffffu); }
__device__ __forceinline__ float sigmoid_f(float x) { return __builtin_amdgcn_rcpf(1.f + __expf(-x)); }
__device__ __forceinline__ float silu_f(float x) { return x * __builtin_amdgcn_rcpf(1.f + __expf(-x)); }
__device__ __forceinline__ float softplus_f(float x) { return fmaxf(x, 0.f) + log1pf(__expf(-fabsf(x))); }

template <int CTRL> __device__ __forceinline__ float dpp_f(float x) {
  return __int_as_float(__builtin_amdgcn_update_dpp(0, __float_as_int(x), CTRL, 0xF, 0xF, true));
}
__device__ __forceinline__ float sum4(float x) { x += dpp_f<0xB1>(x); x += dpp_f<0x4E>(x); return x; }
__device__ __forceinline__ float sum8(float x) { x = sum4(x); x += dpp_f<0x141>(x); return x; }
__device__ __forceinline__ float sum16(float x) { x = sum8(x); x += dpp_f<0x140>(x); return x; }
__device__ __forceinline__ float wave_sum63(float x) {
  x = sum16(x);
  x += __int_as_float(__builtin_amdgcn_update_dpp(0, __float_as_int(x), 0x142, 0xA, 0xF, false));
  x += __int_as_float(__builtin_amdgcn_update_dpp(0, __float_as_int(x), 0x143, 0xC, 0xF, false));
  return x;
}

__device__ __forceinline__ float wave_sum(float x) {
#pragma unroll
  for (int o = 32; o > 0; o >>= 1) x += __shfl_xor(x, o);
  return x;
}

__device__ __forceinline__ void mods_phase(const P& p_unused, char* smem) {
  const P& p = params();
  float* red = (float*)smem;
  float* mods = (float*)(p.ws + OFF_MODS);
  const int tid = ltid(), kq = tid >> 6, col = tid & 63;
  for (int it = lbid(); it < 192; it += gridDim.x) {
    const int l = it / 48, j0 = (it % 48) * 64;
    const float* w = p.ada_w + (size_t)l * 1024 * 3072 + j0 + col;
    float aL = 0.f, aC = 0.f;
    for (int k = kq * 256; k < kq * 256 + 256; ++k) {
      const float wv = w[(size_t)k * 3072];
      aL += silu_f(p.c[k]) * wv;
      aC += silu_f(p.c_ctx[k]) * wv;
    }
    red[(kq * 64 + col) * 2] = aL; red[(kq * 64 + col) * 2 + 1] = aC;
    __syncthreads();
    if (tid < 128) {
      const int cc = tid & 63, which = tid >> 6;
      float s = red[cc * 2 + which] + red[(64 + cc) * 2 + which] + red[(128 + cc) * 2 + which] + red[(192 + cc) * 2 + which];
      mods[(l * 2 + which) * 3072 + j0 + cc] = s + p.ada_b[l * 3072 + j0 + cc];
    }
    __syncthreads();
  }
}

__device__ __forceinline__ void transpose_seg(const float* src, int ldsrc, int K, int src_col0, int len, bf16_t* dst, int dst_row0, int padlen, char* smem) {
  float* tile = (float*)smem;
  const int tid = ltid();
  const int nkt = K / 64, nnt = padlen / 64;
  for (int it = lbid(); it < nkt * nnt; it += gridDim.x) {
    const int nt = it / nkt, kt = it % nkt;
    const int nn4 = (tid & 15) * 4;
#pragma unroll
    for (int i = 0; i < 4; ++i) {
      const int kk = (tid >> 4) + 16 * i;
      f32x4 v = {0.f, 0.f, 0.f, 0.f};
      if (nt * 64 + nn4 < len) v = *(const f32x4*)(src + (size_t)(kt * 64 + kk) * ldsrc + src_col0 + nt * 64 + nn4);
      tile[kk * 65 + nn4] = v[0]; tile[kk * 65 + nn4 + 1] = v[1]; tile[kk * 65 + nn4 + 2] = v[2]; tile[kk * 65 + nn4 + 3] = v[3];
    }
    __syncthreads();
    {
      const int nn = tid >> 2, kq = (tid & 3) * 16;
      u32x4 o0, o1;
      o0[0] = pack2(tile[(kq + 0) * 65 + nn], tile[(kq + 1) * 65 + nn]);
      o0[1] = pack2(tile[(kq + 2) * 65 + nn], tile[(kq + 3) * 65 + nn]);
      o0[2] = pack2(tile[(kq + 4) * 65 + nn], tile[(kq + 5) * 65 + nn]);
      o0[3] = pack2(tile[(kq + 6) * 65 + nn], tile[(kq + 7) * 65 + nn]);
      o1[0] = pack2(tile[(kq + 8) * 65 + nn], tile[(kq + 9) * 65 + nn]);
      o1[1] = pack2(tile[(kq + 10) * 65 + nn], tile[(kq + 11) * 65 + nn]);
      o1[2] = pack2(tile[(kq + 12) * 65 + nn], tile[(kq + 13) * 65 + nn]);
      o1[3] = pack2(tile[(kq + 14) * 65 + nn], tile[(kq + 15) * 65 + nn]);
      bf16_t* d = dst + (size_t)(dst_row0 + nt * 64 + nn) * K + kt * 64 + kq;
      *(u32x4*)d = o0; *(u32x4*)(d + 8) = o1;
    }
    __syncthreads();
  }
}

__device__ __forceinline__ void transposes_for_layer(const P& p_unused, int l, int stage, char* smem) {
  const P& p = params();
  bf16_t* W = (bf16_t*)(p.ws + OFF_R) + E_ELEMS;
  bf16_t* WO = (bf16_t*)(p.ws + OFF_WO);
  const int j = l >> 1;
  const bool ab = (l & 1) == 0;
  const float* win = ab ? p.ab_w_in + (size_t)j * 1024 * 4896 : p.cd_w_in + (size_t)j * 1024 * 7696;
  const float* wout = ab ? p.ab_w_out + (size_t)j * 1536 * 1024 : p.cd_w_out + (size_t)j * 2048 * 1024;
  const int ldw = ab ? 4896 : 7696;
  for (int s = 0; s < 6; ++s) {
    const float* src = win; int ldsrc = ldw, K = 1024, col0 = 0, len = 0, row0 = 0, pad = 0; bf16_t* dst = W;
    if (ab) {
      if (s == 0) { col0 = 3872; len = 1024; row0 = 0; pad = 1024; }
      else if (s == 1) { col0 = 2304; len = 1536; row0 = 1024; pad = 1536; }
      else if (s == 2) { col0 = 3840; len = 32; row0 = 2560; pad = 128; }
      else if (s == 3) { col0 = 0; len = 2304; row0 = 2688; pad = 2304; }
      else if (s == 4) { src = wout; ldsrc = 1024; K = 1536; col0 = 0; len = 1024; row0 = 0; pad = 1024; dst = WO; }
    } else if (stage == 0) {
      if (s == 0) { col0 = 4112; len = 1024; row0 = 0; pad = 1024; }
      else if (s == 1) { col0 = 0; len = 2048; row0 = 1024; pad = 2048; }
      else if (s == 2) { col0 = 2048; len = 1024; row0 = 3072; pad = 1024; }
      else if (s == 3) { col0 = 3072; len = 1024; row0 = 4096; pad = 1024; }
      else if (s == 4) { col0 = 4096; len = 16; row0 = 5120; pad = 128; }
      else { src = wout; ldsrc = 1024; K = 2048; col0 = 0; len = 1024; row0 = 0; pad = 1024; dst = WO; }
    } else {
      if (s == 0) { col0 = 6672; len = 1024; row0 = 0; pad = 1024; }
      else if (s == 1) { col0 = 5136; len = 1024; row0 = 1024; pad = 1024; }
      else if (s == 2) { col0 = 6160; len = 512; row0 = 2048; pad = 512; }
    }
    if (pad > 0) transpose_seg(src, ldsrc, K, col0, len, dst, row0, pad, smem);
  }
}

__device__ __forceinline__ void norm_phase(const P& p_unused, int l) {
  const P& p = params();
  const int tid_ = ltid(); const int lane = tid_ & 63, wv = tid_ >> 6;
  if ((l & 1) == 0) {
    u32x4* z = (u32x4*)((bf16_t*)(p.ws + OFF_U) + (E_ELEMS * 19) / 4);
    for (int i = lbid() * 256 + tid_; i < MT * 64; i += gridDim.x * 256) z[i] = (u32x4){0u, 0u, 0u, 0u};
  }
  bf16_t* H = (bf16_t*)(p.ws + OFF_R);
  const float* mods = (const float*)(p.ws + OFF_MODS);
  const float* g = p.norm_g + l * 1024;
  for (int row = lbid() * 4 + wv; row < MT; row += gridDim.x * 4) {
    const bool isc = row >= TL;
    const float* src = isc ? ((l == 0 ? p.ctx : (const float*)(p.ws + OFF_CTXS)) + (size_t)(row - TL) * 1024)
                           : ((l == 0 ? p.x : p.out) + (size_t)row * 1024);
    const float* md = mods + (l * 2 + (isc ? 1 : 0)) * 3072;
    f32x4 v[4]; float ss = 0.f;
#pragma unroll
    for (int i = 0; i < 4; ++i) { v[i] = *(const f32x4*)(src + i * 256 + lane * 4); ss += v[i][0] * v[i][0] + v[i][1] * v[i][1] + v[i][2] * v[i][2] + v[i][3] * v[i][3]; }
    ss = wave_sum(ss);
    const float rs = rsqrtf(ss * (1.f / 1024.f) + 1e-6f);
#pragma unroll
    for (int i = 0; i < 4; ++i) {
      const int c = i * 256 + lane * 4;
      const f32x4 gg = *(const f32x4*)(g + c), sh = *(const f32x4*)(md + c), sc = *(const f32x4*)(md + 1024 + c);
      float o0 = v[i][0] * rs * gg[0] * (1.f + sc[0]) + sh[0];
      float o1 = v[i][1] * rs * gg[1] * (1.f + sc[1]) + sh[1];
      float o2 = v[i][2] * rs * gg[2] * (1.f + sc[2]) + sh[2];
      float o3 = v[i][3] * rs * gg[3] * (1.f + sc[3]) + sh[3];
      u32x2 o; o[0] = pack2(o0, o1); o[1] = pack2(o2, o3);
      *(u32x2*)(H + (size_t)row * 1024 + c) = o;
    }
  }
}

__device__ __forceinline__ void gemm_phase(const P& p_unused, int kind, int l, char* smem) {
  const P& p = params();
  const int tid = ltid(), lane = tid & 63, wv = tid >> 6, wr = wv >> 1, wc = wv & 1, fr = lane & 15, fq = lane >> 4;
  bf16_t* sA = (bf16_t*)smem;
  bf16_t* sB = sA + 128 * 72;
  bf16_t* Ub = (bf16_t*)(p.ws + OFF_U);
  const bf16_t* Wbase = (const bf16_t*)(p.ws + OFF_R) + E_ELEMS;
  const bf16_t *A1, *A2, *Wt; int ld1, ld2, K1, K, ntN;
  A1 = (const bf16_t*)(p.ws + OFF_R); ld1 = 1024; A2 = A1; ld2 = 1024; K1 = 1024; K = 1024; Wt = Wbase; ntN = 39;
  if (kind == 1) { Wt = Wbase + (size_t)2688 * 1024; ntN = 18; }
  else if (kind == 2) { ntN = 41; }
  else if (kind == 3) { ntN = 20; }
  else if (kind == 4) {
    Wt = (const bf16_t*)(p.ws + OFF_WO); ntN = 8; K = 2048;
    if ((l & 1) == 0) { A1 = Ub + E_ELEMS + 1792; ld1 = 2304; A2 = Ub; ld2 = 1024; K1 = 512; K = 1536; }
    else { A1 = Ub; ld1 = 1024; A2 = Ub + E_ELEMS; ld2 = 1024; }
  }
  const float* mods = (const float*)(p.ws + OFF_MODS);
  const int ntiles = (MT / 128) * ntN;
  for (int tile = lbid(); tile < ntiles; tile += gridDim.x) {
    const int tm = tile / ntN, tn = tile % ntN;
    f32x4 acc[4][4];
#pragma unroll
    for (int a = 0; a < 4; ++a)
#pragma unroll
      for (int b = 0; b < 4; ++b) acc[a][b] = (f32x4){0.f, 0.f, 0.f, 0.f};
    u32x4 ra[4], rb[4];
    {
#pragma unroll
      for (int i = 0; i < 4; ++i) {
        const int id = tid + 256 * i, r = id >> 3, kc = (id & 7) * 8;
        ra[i] = *(const u32x4*)(A1 + (size_t)(tm * 128 + r) * ld1 + kc);
        rb[i] = *(const u32x4*)(Wt + (size_t)(tn * 128 + r) * K + kc);
      }
    }
    for (int k0 = 0; k0 < K; k0 += 64) {
      __syncthreads();
#pragma unroll
      for (int i = 0; i < 4; ++i) {
        const int id = tid + 256 * i, r = id >> 3, kc = (id & 7) * 8;
        *(u32x4*)(sA + r * 72 + kc) = ra[i];
        *(u32x4*)(sB + r * 72 + kc) = rb[i];
      }
      __syncthreads();
      if (k0 + 64 < K) {
        const int kn = k0 + 64;
        const bf16_t* Ap; int ldp, kk;
        if (kn < K1) { Ap = A1; ldp = ld1; kk = kn; } else { Ap = A2; ldp = ld2; kk = kn - K1; }
#pragma unroll
        for (int i = 0; i < 4; ++i) {
          const int id = tid + 256 * i, r = id >> 3, kc = (id & 7) * 8;
          ra[i] = *(const u32x4*)(Ap + (size_t)(tm * 128 + r) * ldp + kk + kc);
          rb[i] = *(const u32x4*)(Wt + (size_t)(tn * 128 + r) * K + kn + kc);
        }
      }
#pragma unroll
      for (int ks = 0; ks < 2; ++ks) {
        bf16x8 af[4], bfr[4];
#pragma unroll
        for (int m = 0; m < 4; ++m) af[m] = *(const bf16x8*)(sA + (wr * 64 + m * 16 + fr) * 72 + ks * 32 + fq * 8);
#pragma unroll
        for (int n = 0; n < 4; ++n) bfr[n] = *(const bf16x8*)(sB + (wc * 64 + n * 16 + fr) * 72 + ks * 32 + fq * 8);
#pragma unroll
        for (int m = 0; m < 4; ++m)
#pragma unroll
          for (int n = 0; n < 4; ++n) acc[m][n] = __builtin_amdgcn_mfma_f32_16x16x32_bf16(af[m], bfr[n], acc[m][n], 0, 0, 0);
      }
    }
    if (kind == 4) {
      const float* gl = mods + (l * 2 + 0) * 3072 + 2048;
      const float* gc = mods + (l * 2 + 1) * 3072 + 2048;
      const float* xin = (l == 0) ? p.x : p.out;
      const float* cin = (l == 0) ? p.ctx : (const float*)(p.ws + OFF_CTXS);
      float* cout = (float*)(p.ws + OFF_CTXS);
#pragma unroll
      for (int m = 0; m < 4; ++m)
#pragma unroll
        for (int n = 0; n < 4; ++n) {
          const int col = tn * 128 + wc * 64 + n * 16 + fr;
#pragma unroll
          for (int jj = 0; jj < 4; ++jj) {
            const int row = tm * 128 + wr * 64 + m * 16 + fq * 4 + jj;
            if (row < TL) p.out[(size_t)row * 1024 + col] = xin[(size_t)row * 1024 + col] + gl[col] * acc[m][n][jj];
            else cout[(size_t)(row - TL) * 1024 + col] = cin[(size_t)(row - TL) * 1024 + col] + gc[col] * acc[m][n][jj];
          }
        }
    } else {
      bf16_t* out = Ub; int ld = 1024, cbase = 0, valid = 128 * 64; float* fout = nullptr; int fld = 0;
      float* fside = (float*)(p.ws + OFF_FSIDE);
      if (kind == 0) {
        if (tn < 8) { out = Ub; ld = 1024; cbase = tn * 128; valid = 1024; }
        else if (tn < 20) { out = Ub + (E_ELEMS * 13) / 4; ld = 1536; cbase = (tn - 8) * 128; valid = 1536; }
        else if (tn == 20) { fout = fside; fld = 32; cbase = 0; valid = 32; }
        else { out = Ub + E_ELEMS; ld = 2304; cbase = (tn - 21) * 128; valid = 2304; }
      } else if (kind == 1) { out = Ub + E_ELEMS; ld = 2304; cbase = tn * 128; valid = 2304; }
      else if (kind == 2) {
        if (tn < 8) { out = Ub; ld = 1024; cbase = tn * 128; valid = 1024; }
        else if (tn < 24) { out = Ub + E_ELEMS; ld = 2048; cbase = (tn - 8) * 128; valid = 2048; }
        else if (tn < 32) { out = Ub + 3 * E_ELEMS; ld = 1024; cbase = (tn - 24) * 128; valid = 1024; }
        else if (tn < 40) { out = Ub + 4 * E_ELEMS; ld = 1024; cbase = (tn - 32) * 128; valid = 1024; }
        else { fout = fside; fld = 16; cbase = 0; valid = 16; }
      } else {
        if (tn < 8) { out = Ub + E_ELEMS; ld = 1024; cbase = tn * 128; valid = 1024; }
        else if (tn < 16) { out = Ub + 2 * E_ELEMS; ld = 1024; cbase = (tn - 8) * 128; valid = 1024; }
        else { out = Ub + 3 * E_ELEMS; ld = 512; cbase = (tn - 16) * 128; valid = 512; }
      }
#pragma unroll
      for (int m = 0; m < 4; ++m)
#pragma unroll
        for (int n = 0; n < 4; ++n) {
          const int col = cbase + wc * 64 + n * 16 + fr;
          if (col < valid) {
#pragma unroll
            for (int jj = 0; jj < 4; ++jj) {
              const int row = tm * 128 + wr * 64 + m * 16 + fq * 4 + jj;
              if (fout) fout[(size_t)row * fld + col] = (kind == 0) ? softplus_f(acc[m][n][jj] + p.mb_dt_bias[(l >> 1) * 32 + col]) : acc[m][n][jj];
              else out[(size_t)row * ld + col] = f2bf(acc[m][n][jj]);
            }
          }
        }
    }
  }
}

__device__ __forceinline__ void chunk_pos(int ci, int dir, int& rbase, int& t0, int& Ls) {
  const bool isc = ci < 8;
  int cidx = isc ? ci : ci - 8;
  const int nseg = isc ? 8 : 512;
  if (dir) cidx = nseg - 1 - cidx;
  Ls = isc ? TC : TL; rbase = isc ? TL : 0; t0 = cidx * 32;
}

#define LDS_BARRIER() do { asm volatile("s_waitcnt lgkmcnt(0)" ::: "memory"); __builtin_amdgcn_s_barrier(); } while (0)

__device__ __forceinline__ void rwkv_scan(const P& p_unused, int j, char* smem, int bid) {
  const P& p = params();
  const int tid = ltid(), lane = tid & 63, wv = tid >> 6, fr = lane & 15, fq = lane >> 4;
  const int dir = bid >> 5, head = (bid >> 2) & 7, qr = bid & 3;
  float* sR = (float*)smem;
  float* sK = sR + 2048;
  float* sW = sK + 2048;
  float* sKK = sW + 2048;
  float* sKA = sKK + 2048;
  float* sV = sKA + 2048;
  float* sY = sV + 512;
  bf16_t* sTW = (bf16_t*)(sY + 512);
  bf16_t* sAL = sTW + 32 * 72;
  float* sP = (float*)(sAL + 32 * 72);
  float* sDum = sP + 32 * 128;
  const bf16_t* U = (const bf16_t*)(p.ws + OFF_U) + E_ELEMS;
  bf16_t* ysum = (bf16_t*)(p.ws + OFF_U) + (E_ELEMS * 19) / 4;
  float* bonus = (float*)(p.ws + OFF_BONUS) + (size_t)dir * MT * 8;
  const float* mu = p.rk_mu + j * 1792;
  const float* w0 = p.rk_w0 + (j * 2 + dir) * 512 + head * 64;
  const float* a0 = p.rk_a0 + (j * 2 + dir) * 512 + head * 64;
  const float* kkw = p.rk_k_k + j * 512 + head * 64;
  const float* kaw = p.rk_k_a + j * 512 + head * 64;
  const float* rkw = p.rk_r_k + j * 512 + head * 64;
  const int path = wv >> 1, mt = wv & 1;
  const float* l2 = (path ? p.rk_a2 : p.rk_w2) + (size_t)(j * 2 + dir) * 64 * 512 + head * 64;
  bf16x8 bfrag[4][2];
#pragma unroll
  for (int nt = 0; nt < 4; ++nt)
#pragma unroll
    for (int ks = 0; ks < 2; ++ks)
#pragma unroll
      for (int jj = 0; jj < 8; ++jj) bfrag[nt][ks][jj] = (short)f2bf(l2[(size_t)(ks * 32 + fq * 8 + jj) * 512 + nt * 16 + fr]);
  const int ccA = (tid & 127) * 2, hA = tid >> 7;
  const int ttB = tid >> 3, ccB = (tid & 7) * 2;
  int gcA;
  if (ccA < 64) gcA = head * 64 + ccA; else if (ccA < 128) gcA = 512 + head * 64 + ccA - 64;
  else if (ccA < 192) gcA = 1536 + dir * 64 + ccA - 128; else gcA = 1664 + dir * 64 + ccA - 192;
  const float muA0 = mu[gcA], muA1 = mu[gcA + 1];
  const float muB0 = mu[1024 + head * 64 + qr * 16 + ccB], muB1 = mu[1024 + head * 64 + qr * 16 + ccB + 1];
  float cB[4];
#pragma unroll
  for (int nt = 0; nt < 4; ++nt) cB[nt] = (path ? a0 : w0)[nt * 16 + fr];
  float cKK[4], cKA[4], cRK[4];
#pragma unroll
  for (int i = 0; i < 4; ++i) { const int col = i * 16 + (tid & 15); cKK[i] = kkw[col]; cKA[i] = kaw[col]; cRK[i] = rkw[col]; }
  u32x4 pre[5];
#define RWKV_ISSUE(CI)                                                                                   \
  {                                                                                                      \
    int rb_, t0_, Ls_; chunk_pos((CI), dir, rb_, t0_, Ls_);                                              \
    _Pragma("unroll") for (int i = 0; i < 5; ++i) {                                                      \
      const int idx = tid + 256 * i;                                                                     \
      pre[i] = (u32x4){0u, 0u, 0u, 0u};                                                                  \
      if (idx < 1088) {                                                                                  \
        const int row = idx / 34, v = idx - row * 34, t = t0_ + row;                                     \
        int gc;                                                                                          \
        if (v < 8) gc = head * 64 + v * 8; else if (v < 16) gc = 512 + head * 64 + (v - 8) * 8;          \
        else if (v < 24) gc = 1536 + dir * 64 + (v - 16) * 8; else if (v < 32) gc = 1664 + dir * 64 + (v - 24) * 8; \
        else gc = 1024 + head * 64 + qr * 16 + (v - 32) * 8;                                             \
        if (t >= 0 && t < Ls_) pre[i] = *(const u32x4*)(U + (size_t)(rb_ + t) * 2304 + gc);             \
      }                                                                                                  \
    }                                                                                                    \
  }
#define RWKV_COMMIT()                                                                                    \
  {                                                                                                      \
    _Pragma("unroll") for (int i = 0; i < 5; ++i) {                                                      \
      const int idx = tid + 256 * i;                                                                     \
      if (idx < 1088) {                                                                                  \
        const int row = idx / 34, v = idx - row * 34;                                                    \
        if (v >= 16 && v < 32) *(u32x4*)(((v < 24) ? sTW + row * 72 + (v - 16) * 8 : sAL + row * 72 + (v - 24) * 8)) = pre[i]; \
        else {                                                                                           \
          float* d = (v < 8) ? sR + row * 64 + v * 8 : ((v < 16) ? sK + row * 64 + (v - 8) * 8 : sV + row * 16 + (v - 32) * 8); \
          f32x4 lo, hi;                                                                                  \
          lo[0] = __uint_as_float(pre[i][0] << 16); lo[1] = __uint_as_float(pre[i][0] & 0xffff0000u);    \
          lo[2] = __uint_as_float(pre[i][1] << 16); lo[3] = __uint_as_float(pre[i][1] & 0xffff0000u);    \
          hi[0] = __uint_as_float(pre[i][2] << 16); hi[1] = __uint_as_float(pre[i][2] & 0xffff0000u);    \
          hi[2] = __uint_as_float(pre[i][3] << 16); hi[3] = __uint_as_float(pre[i][3] & 0xffff0000u);    \
          *(f32x4*)d = lo; *(f32x4*)(d + 4) = hi;                                                        \
        }                                                                                                \
      }                                                                                                  \
    }                                                                                                    \
  }
  RWKV_ISSUE(0);
  RWKV_COMMIT();
  __syncthreads();
  typedef float f32x2v __attribute__((ext_vector_type(2)));
  f32x2v SA = {0.f, 0.f}, SB = {0.f, 0.f};
  for (int ci = 0; ci < 520; ++ci) {
    int rbase, t0, Ls; chunk_pos(ci, dir, rbase, t0, Ls);
    {
      const bf16_t* sX = path ? sAL : sTW;
      f32x4 acc[4];
#pragma unroll
      for (int nt = 0; nt < 4; ++nt) acc[nt] = (f32x4){0.f, 0.f, 0.f, 0.f};
#pragma unroll
      for (int ks = 0; ks < 2; ++ks) {
        const bf16x8 a = *(const bf16x8*)(sX + (mt * 16 + fr) * 72 + ks * 32 + fq * 8);
#pragma unroll
        for (int nt = 0; nt < 4; ++nt) acc[nt] = __builtin_amdgcn_mfma_f32_16x16x32_bf16(a, bfrag[nt][ks], acc[nt], 0, 0, 0);
      }
#pragma unroll
      for (int nt = 0; nt < 4; ++nt)
#pragma unroll
        for (int jj = 0; jj < 4; ++jj) {
          const int tok = mt * 16 + fq * 4 + jj, col = nt * 16 + fr;
          const float v = acc[nt][jj];
          if (path == 0) { const float sg = sigmoid_f(cB[nt] + v); sW[tok * 64 + col] = __expf(-0.6065306597f * sg); }
          else sKA[tok * 64 + col] = sigmoid_f(cB[nt] + v);
        }
    }
    LDS_BARRIER();
    {
      const int part = tid & 15;
#pragma unroll
      for (int ps = 0; ps < 2; ++ps) {
        const int tt = ps * 16 + (tid >> 4);
        float kk[4], aa[4]; float ss = 0.f, bon = 0.f;
#pragma unroll
        for (int i = 0; i < 4; ++i) {
          const int col = i * 16 + part;
          const float k = sK[tt * 64 + col], a = sKA[tt * 64 + col], r = sR[tt * 64 + col];
          const float kv = k * cKK[i];
          kk[i] = kv; aa[i] = a; ss += kv * kv;
          const float kd = k * (1.f + (a - 1.f) * cKA[i]);
          sK[tt * 64 + col] = kd;
          bon += r * kd * cRK[i];
        }
        ss = sum16(ss); bon = sum16(bon);
        const float inv = __builtin_amdgcn_rcpf(fmaxf(__builtin_amdgcn_sqrtf(ss), 1e-12f));
#pragma unroll
        for (int i = 0; i < 4; ++i) {
          const int col = i * 16 + part;
          const float kn = kk[i] * inv;
          sKK[tt * 64 + col] = kn; sKA[tt * 64 + col] = kn * aa[i];
        }
        if (part == 0 && qr == 0) bonus[(size_t)(rbase + t0 + tt) * 8 + head] = bon;
      }
    }
    LDS_BARRIER();
    if (ci + 1 < 520) RWKV_ISSUE(ci + 1);
    {
      const int vr = tid >> 4, pp = tid & 15;
#define RW_LOAD(TT, R4, KD4, W4, KK4, KA4, VV)                                                          \
      R4 = *(const f32x4*)(sR + (TT) * 64 + pp * 4); KD4 = *(const f32x4*)(sK + (TT) * 64 + pp * 4);    \
      W4 = *(const f32x4*)(sW + (TT) * 64 + pp * 4); KK4 = *(const f32x4*)(sKK + (TT) * 64 + pp * 4);   \
      KA4 = *(const f32x4*)(sKA + (TT) * 64 + pp * 4); VV = sV[(TT) * 16 + vr];
#define RW_SCAN(TTOF)                                                                                   \
      {                                                                                                 \
        f32x4 r4, kd4, w4, kk4, ka4; float vv;                                                          \
        f32x4 mr4, mkd4, mw4, mkk4, mka4; float mvv;     \
        RW_LOAD(TTOF(0), r4, kd4, w4, kk4, ka4, vv)                                                     \
        RW_LOAD(TTOF(1), mr4, mkd4, mw4, mkk4, mka4, mvv)                                               \
        _Pragma("unroll") for (int s = 0; s < 32; ++s) {                                                \
          f32x4 nr4 = mr4, nkd4 = mkd4, nw4 = mw4, nkk4 = mkk4, nka4 = mka4; float nvv = mvv;           \
          if (s + 2 < 32) { RW_LOAD(TTOF(s + 2), mr4, mkd4, mw4, mkk4, mka4, mvv) }                     \
          const f32x2v kkA = {kk4[0], kk4[1]}, kkB = {kk4[2], kk4[3]}, wA = {w4[0], w4[1]}, wB = {w4[2], w4[3]};      \
          const f32x2v kaA = {ka4[0], ka4[1]}, kaB = {ka4[2], ka4[3]}, kdA = {kd4[0], kd4[1]}, kdB = {kd4[2], kd4[3]};  \
          const f32x2v rA = {r4[0], r4[1]}, rB = {r4[2], r4[3]};                                          \
          f32x2v td = SA * kkA; td = SB * kkB + td;                                                       \
          float d = td[0] + td[1];                                                                      \
          const f32x2v vv2 = {vv, vv};                                                                    \
          const f32x2v uA = vv2 * kdA + SA * wA, uB = vv2 * kdB + SB * wB;     \
          d = sum16(d);                                                                                 \
          const f32x2v nd2 = {-d, -d};                                                                    \
          SA = nd2 * kaA + uA;                                                                            \
          SB = nd2 * kaB + uB;                                                                            \
          f32x2v ty = SA * rA; ty = SB * rB + ty;                                                         \
          float y = ty[0] + ty[1];                                                                      \
          y += dpp_f<0xB1>(y);                                                                          \
          *(((pp & 1) == 0) ? (sP + TTOF(s) * 128 + (tid >> 1)) : (sDum + lane)) = y;                   \
          r4 = nr4; kd4 = nkd4; w4 = nw4; kk4 = nkk4; ka4 = nka4; vv = nvv;                             \
        }                                                                                               \
      }
#define TT_FWD(S) (S)
#define TT_BWD(S) (31 - (S))
      if (dir) RW_SCAN(TT_BWD) else RW_SCAN(TT_FWD)
#undef RW_LOAD
#undef RW_SCAN
    }
    LDS_BARRIER();
    {
      const int tt = tid >> 3, pr = (tid & 7) * 2;
      typedef short s2_t __attribute__((ext_vector_type(2)));
      const float* pq = sP + tt * 128 + pr * 8;
      const f32x4 q0 = *(const f32x4*)pq, q1 = *(const f32x4*)(pq + 4), q2 = *(const f32x4*)(pq + 8), q3 = *(const f32x4*)(pq + 12);
      const unsigned pk = pack2(((q0[0] + q0[1]) + (q0[2] + q0[3])) + ((q1[0] + q1[1]) + (q1[2] + q1[3])),
                                ((q2[0] + q2[1]) + (q2[2] + q2[3])) + ((q3[0] + q3[1]) + (q3[2] + q3[3])));
      __builtin_amdgcn_global_atomic_fadd_v2bf16((s2_t __attribute__((address_space(1)))*)(ysum + (size_t)(rbase + t0 + tt) * 512 + head * 64 + qr * 16 + pr),
                                                 __builtin_bit_cast(s2_t, pk));
    }
    if (ci + 1 < 520) RWKV_COMMIT();
    LDS_BARRIER();
  }
#undef RWKV_ISSUE
#undef RWKV_COMMIT
}

__device__ __forceinline__ void unpack8(const u32x4 v, float* x) {
#pragma unroll
  for (int e = 0; e < 4; ++e) { x[2 * e] = __uint_as_float(v[e] << 16); x[2 * e + 1] = __uint_as_float(v[e] & 0xffff0000u); }
}
__device__ __forceinline__ void rwkv_post(const P& p_unused, int j) {
  const P& p = params();
  const int tid_ = ltid(); const int lane = tid_ & 63, wv = tid_ >> 6;
  bf16_t* U = (bf16_t*)(p.ws + OFF_U) + E_ELEMS;
  const bf16_t* ys = (const bf16_t*)(p.ws + OFF_U) + (E_ELEMS * 19) / 4;
  const float* bonf = (const float*)(p.ws + OFF_BONUS);
  const float* bonb = bonf + (size_t)MT * 8;
  const int c0 = lane * 8, head = lane >> 3;
  float mu[8], lw[8], lb[8];
  {
    const float* mup = p.rk_mu + j * 1792 + 1024 + c0; const float* lwp = p.rk_ln_w + j * 512 + c0; const float* lbp = p.rk_ln_b + j * 512 + c0;
#pragma unroll
    for (int i = 0; i < 8; ++i) { mu[i] = mup[i]; lw[i] = lwp[i]; lb[i] = lbp[i]; }
  }
  for (int row = lbid() * 4 + wv; row < MT; row += gridDim.x * 4) {
    const int t = row < TL ? row : row - TL; const int Ls = row < TL ? TL : TC;
    bf16_t* urow = U + (size_t)row * 2304;
    float y[8], v0[8], vm[8], vp[8], ga[8];
    unpack8(*(const u32x4*)(ys + (size_t)row * 512 + c0), y);
    unpack8(*(const u32x4*)(urow + 1024 + c0), v0);
    unpack8(*(const u32x4*)(urow + 1792 + c0), ga);
    const u32x4 zero = {0u, 0u, 0u, 0u};
    unpack8((t > 0) ? *(const u32x4*)(urow + 1024 + c0 - 2304) : zero, vm);
    unpack8((t < Ls - 1) ? *(const u32x4*)(urow + 1024 + c0 + 2304) : zero, vp);
    float sm = 0.f;
#pragma unroll
    for (int i = 0; i < 8; ++i) sm += y[i];
    sm = sum8(sm);
    const float mean = sm * (1.f / 64.f);
    float vs = 0.f;
#pragma unroll
    for (int i = 0; i < 8; ++i) { const float d = y[i] - mean; vs += d * d; }
    vs = sum8(vs);
    const float rstd = rsqrtf(vs * (1.f / 64.f) + 64e-5f);
    const float bon = bonf[(size_t)row * 8 + head] + bonb[(size_t)row * 8 + head];
    float o[8];
#pragma unroll
    for (int i = 0; i < 8; ++i) {
      o[i] = ((y[i] - mean) * rstd * lw[i] + lb[i] + bon * v0[i]) * silu_f(ga[i]);
    }
    u32x4 ov; ov[0] = pack2(o[0], o[1]); ov[1] = pack2(o[2], o[3]); ov[2] = pack2(o[4], o[5]); ov[3] = pack2(o[6], o[7]);
    *(u32x4*)(urow + 1792 + c0) = ov;
  }
}

__device__ __forceinline__ void mamba_scan(const P& p_unused, int j, char* smem, int bid) {
  const P& p = params();
  const int tid = ltid();
  const int dir = bid >> 6, head = (bid >> 2) & 15, qr = bid & 3, g = head >> 3;
  float* sB = (float*)smem;
  float* sC = sB + 4096;
  float* sX = sC + 4096;
  float* sDA = sX + 512;
  float* sDT = sDA + 32;
  float* sY = sDT + 32;
  float* sDum = sY + 512;
  float* sP = sDum + 64;
  const bf16_t* XBC = (const bf16_t*)(p.ws + OFF_U) + (E_ELEMS * 13) / 4;
  const float* fs = (const float*)(p.ws + OFF_FSIDE);
  bf16_t* ydir = (bf16_t*)(p.ws + OFF_R) + (size_t)dir * E_ELEMS;
  const float Aneg = -__expf(p.mb_a_log[(j * 2 + dir) * 16 + head]);
  const int ccA = (tid & 127) * 2, hA = tid >> 7;
  const int ttB = tid >> 3, ccB = 256 + (tid & 7) * 2;
  u32x4 pre[5]; float predt = 0.f;
#define MB_ISSUE(CI)                                                                                     \
  {                                                                                                      \
    int rb_, t0_, Ls_; chunk_pos((CI), dir, rb_, t0_, Ls_);                                              \
    _Pragma("unroll") for (int i = 0; i < 5; ++i) {                                                      \
      const int idx = tid + 256 * i;                                                                     \
      pre[i] = (u32x4){0u, 0u, 0u, 0u};                                                                  \
      if (idx < 1088) {                                                                                  \
        const int row = idx / 34, v = idx - row * 34;                                                    \
        const int gc = (v < 2) ? head * 64 + qr * 16 + v * 8 : ((v < 18) ? 1024 + g * 128 + (v - 2) * 8 : 1280 + g * 128 + (v - 18) * 8); \
        pre[i] = *(const u32x4*)(XBC + (size_t)(rb_ + t0_ + row) * 1536 + gc);                           \
      }                                                                                                  \
    }                                                                                                    \
    if (tid < 32) predt = fs[(size_t)(rb_ + t0_ + tid) * 32 + dir * 16 + head];                          \
  }
#define MB_COMMIT()                                                                                      \
  {                                                                                                      \
    _Pragma("unroll") for (int i = 0; i < 5; ++i) {                                                      \
      const int idx = tid + 256 * i;                                                                     \
      if (idx < 1088) {                                                                                  \
        const int row = idx / 34, v = idx - row * 34;                                                    \
        float* d = (v < 2) ? sX + row * 16 + v * 8 : ((v < 18) ? sB + row * 128 + (v - 2) * 8 : sC + row * 128 + (v - 18) * 8); \
        f32x4 lo, hi;                                                                                    \
        lo[0] = __uint_as_float(pre[i][0] << 16); lo[1] = __uint_as_float(pre[i][0] & 0xffff0000u);      \
        lo[2] = __uint_as_float(pre[i][1] << 16); lo[3] = __uint_as_float(pre[i][1] & 0xffff0000u);      \
        hi[0] = __uint_as_float(pre[i][2] << 16); hi[1] = __uint_as_float(pre[i][2] & 0xffff0000u);      \
        hi[2] = __uint_as_float(pre[i][3] << 16); hi[3] = __uint_as_float(pre[i][3] & 0xffff0000u);      \
        *(f32x4*)d = lo; *(f32x4*)(d + 4) = hi;                                                          \
      }                                                                                                  \
    }                                                                                                    \
    if (tid < 32) { sDT[tid] = predt; sDA[tid] = __expf(predt * Aneg); }                                 \
  }
  MB_ISSUE(0);
  MB_COMMIT();
  __syncthreads();
  float S[8];
#pragma unroll
  for (int i = 0; i < 8; ++i) S[i] = 0.f;
  for (int ci = 0; ci < 520; ++ci) {
    int rbase, t0, Ls; chunk_pos(ci, dir, rbase, t0, Ls);
    { const int e = tid * 2; const float dt = sDT[e >> 4]; sX[e] *= dt; sX[e + 1] *= dt; }
    LDS_BARRIER();
    if (ci + 1 < 520) MB_ISSUE(ci + 1);
    {
      const int pr = tid >> 4, part = tid & 15;
#define MB_LOAD(TT, B0, B1, C0, C1, XD, DA)                                                             \
      B0 = *(const f32x4*)(sB + (TT) * 128 + part * 4); B1 = *(const f32x4*)(sB + (TT) * 128 + 64 + part * 4); \
      C0 = *(const f32x4*)(sC + (TT) * 128 + part * 4); C1 = *(const f32x4*)(sC + (TT) * 128 + 64 + part * 4); \
      XD = sX[(TT) * 16 + pr]; DA = sDA[(TT)];
#define MB_SCAN(TTOF)                                                                                   \
      {                                                                                                 \
        f32x4 b0, b1, c0, c1; float xdt, da;                                                            \
        MB_LOAD(TTOF(0), b0, b1, c0, c1, xdt, da)                                                       \
        _Pragma("unroll") for (int s = 0; s < 32; ++s) {                                                \
          f32x4 nb0 = b0, nb1 = b1, nc0 = c0, nc1 = c1; float nxdt = xdt, nda = da;                     \
          if (s + 1 < 32) { MB_LOAD(TTOF(s + 1), nb0, nb1, nc0, nc1, nxdt, nda) }                       \
          float y = 0.f;                                                                                \
          _Pragma("unroll") for (int i = 0; i < 4; ++i) { S[i] = S[i] * da + xdt * b0[i]; y += S[i] * c0[i]; }             \
          _Pragma("unroll") for (int i = 0; i < 4; ++i) { S[4 + i] = S[4 + i] * da + xdt * b1[i]; y += S[4 + i] * c1[i]; } \
          sP[TTOF(s) * 256 + tid] = y;                                                                  \
          b0 = nb0; b1 = nb1; c0 = nc0; c1 = nc1; xdt = nxdt; da = nda;                                 \
        }                                                                                               \
      }
      if (dir) MB_SCAN(TT_BWD) else MB_SCAN(TT_FWD)
#undef MB_LOAD
#undef MB_SCAN
    }
    LDS_BARRIER();
    for (int e = tid; e < 512; e += 256) {
      const int tt = e >> 4, pr = e & 15;
      const float* pp = sP + tt * 256 + pr * 16;
      const f32x4 p0 = *(const f32x4*)pp, p1 = *(const f32x4*)(pp + 4), p2 = *(const f32x4*)(pp + 8), p3 = *(const f32x4*)(pp + 12);
      const float ys = ((p0[0] + p0[1]) + (p0[2] + p0[3])) + ((p1[0] + p1[1]) + (p1[2] + p1[3])) + ((p2[0] + p2[1]) + (p2[2] + p2[3])) + ((p3[0] + p3[1]) + (p3[2] + p3[3]));
      ydir[(size_t)(rbase + t0 + tt) * 1024 + head * 64 + qr * 16 + pr] = f2bf(ys);
    }
    if (ci + 1 < 520) MB_COMMIT();
    LDS_BARRIER();
  }
#undef MB_ISSUE
#undef MB_COMMIT
}

__device__ __forceinline__ void mamba_post(const P& p_unused, int j) {
  const P& p = params();
  const int tid_ = ltid(); const int lane = tid_ & 63, wv = tid_ >> 6;
  bf16_t* Z = (bf16_t*)(p.ws + OFF_U);
  const bf16_t* XBC = (const bf16_t*)(p.ws + OFF_U) + (E_ELEMS * 13) / 4;
  const bf16_t* yf = (const bf16_t*)(p.ws + OFF_R);
  const bf16_t* yb = yf + E_ELEMS;
  const float* cw = p.mb_conv_w + (size_t)j * 5 * 1536;
  const float* cb = p.mb_conv_b + j * 1536;
  const float* nw = p.mb_norm_w + j * 1024;
  for (int row = lbid() * 4 + wv; row < MT; row += gridDim.x * 4) {
    const int t = row < TL ? row : row - TL; const int Ls = row < TL ? TL : TC;
    float y[4][4]; float ssg[2] = {0.f, 0.f};
#pragma unroll
    for (int i = 0; i < 4; ++i) {
      const int c = i * 256 + lane * 4;
      const u32x2 xv = *(const u32x2*)(XBC + (size_t)row * 1536 + c);
      const float a0 = __uint_as_float(xv[0] << 16), a1 = __uint_as_float(xv[0] & 0xffff0000u), a2 = __uint_as_float(xv[1] << 16), a3 = __uint_as_float(xv[1] & 0xffff0000u);
      const float dsk = p.mb_d[j * 16 + (c >> 6)];
      const u32x2 f = *(const u32x2*)(yf + (size_t)row * 1024 + c), b = *(const u32x2*)(yb + (size_t)row * 1024 + c), z = *(const u32x2*)(Z + (size_t)row * 1024 + c);
      float v0 = __uint_as_float(f[0] << 16) + __uint_as_float(b[0] << 16) + dsk * a0;
      float v1 = __uint_as_float(f[0] & 0xffff0000u) + __uint_as_float(b[0] & 0xffff0000u) + dsk * a1;
      float v2 = __uint_as_float(f[1] << 16) + __uint_as_float(b[1] << 16) + dsk * a2;
      float v3 = __uint_as_float(f[1] & 0xffff0000u) + __uint_as_float(b[1] & 0xffff0000u) + dsk * a3;
      v0 *= silu_f(__uint_as_float(z[0] << 16)); v1 *= silu_f(__uint_as_float(z[0] & 0xffff0000u));
      v2 *= silu_f(__uint_as_float(z[1] << 16)); v3 *= silu_f(__uint_as_float(z[1] & 0xffff0000u));
      y[i][0] = v0; y[i][1] = v1; y[i][2] = v2; y[i][3] = v3;
      ssg[i >> 1] += v0 * v0 + v1 * v1 + v2 * v2 + v3 * v3;
    }
    const float s0 = wave_sum(ssg[0]), s1 = wave_sum(ssg[1]);
    const float r0 = rsqrtf(s0 * (1.f / 512.f) + 1e-6f), r1 = rsqrtf(s1 * (1.f / 512.f) + 1e-6f);
#pragma unroll
    for (int i = 0; i < 4; ++i) {
      const int c = i * 256 + lane * 4;
      const float rs = (i < 2) ? r0 : r1;
      const f32x4 w = *(const f32x4*)(nw + c);
      u32x2 o; o[0] = pack2(y[i][0] * rs * w[0], y[i][1] * rs * w[1]); o[1] = pack2(y[i][2] * rs * w[2], y[i][3] * rs * w[3]);
      *(u32x2*)(Z + (size_t)row * 1024 + c) = o;
    }
  }
}

__device__ __forceinline__ void ml_prep(const P& p_unused, int j) {
  const P& p = params();
  const int tid = ltid(), lane = tid & 63, wv = tid >> 6, bid = lbid();
  const float* fs = (const float*)(p.ws + OFF_FSIDE);
  f32x4* gates = (f32x4*)(p.ws + OFF_BONUS);
  if (bid < 2) {
    const int chain = bid * 4 + wv, dir = chain >> 2, head = chain & 3;
    const float ib = p.ml_i_bias[(j * 2 + dir) * 4 + head];
    const float fb = p.ml_f_bias[(j * 2 + dir) * 4 + head];
    float m_in = 0.f;
    float nf, ni;
    { const int row0 = TL + (dir ? TC - 1 - lane : lane); nf = fs[(size_t)row0 * 16 + 8 + dir * 4 + head]; ni = fs[(size_t)row0 * 16 + dir * 4 + head]; }
    for (int blk = 0; blk < 260; ++blk) {
      const bool isc = blk < 4;
      const int tb = isc ? blk : blk - 4, Ls = isc ? TC : TL, rbase = isc ? TL : 0;
      const int tpos = tb * 64 + lane;
      const int row = rbase + (dir ? Ls - 1 - tpos : tpos);
      const float rawf = nf, rawi = ni;
      if (blk + 1 < 260) {
        const int b2 = blk + 1; const bool isc2 = b2 < 4;
        const int tb2 = isc2 ? b2 : b2 - 4, Ls2 = isc2 ? TC : TL, rbase2 = isc2 ? TL : 0;
        const int tp2 = tb2 * 64 + lane;
        const float* f2 = fs + (size_t)(rbase2 + (dir ? Ls2 - 1 - tp2 : tp2)) * 16;
        nf = f2[8 + dir * 4 + head]; ni = f2[dir * 4 + head];
      }
      const float xf = rawf + fb;
      const float lf = fminf(xf, 0.f) - log1pf(__expf(-fabsf(xf)));
      const float ig = rawi + ib;
      float a = lf, b = ig;
#pragma unroll
      for (int off = 1; off < 64; off <<= 1) {
        const float a2 = __shfl_up(a, off), b2 = __shfl_up(b, off);
        if (lane >= off) { b = fmaxf(b2 + a, b); a = a2 + a; }
      }
      const float m = fmaxf(m_in + a, b);
      float mp = __shfl_up(m, 1);
      if (lane == 0) mp = m_in;
      gates[(size_t)chain * MT + row] = (f32x4){lf + mp - m, ig - m, __expf(-m), 0.f};
      m_in = __shfl(m, 63);
    }
  }
  const bf16_t* QK = (const bf16_t*)(p.ws + OFF_U) + E_ELEMS;
  bf16_t* QKC = (bf16_t*)(p.ws + OFF_R);
  const float* cw = p.ml_conv_w + (size_t)j * 5 * 2048;
  const float* cb = p.ml_conv_b + j * 2048;
  for (int it = bid * 256 + tid; it < (MT / 4) * 256; it += gridDim.x * 256) {
    const int vc = it & 255, r0 = (it >> 8) * 4, c = vc * 8;
    const int t0 = r0 < TL ? r0 : r0 - TL, Ls = r0 < TL ? TL : TC;
    float w[5][8], bias[8];
#pragma unroll
    for (int q = 0; q < 5; ++q) {
      const f32x4 wa = *(const f32x4*)(cw + q * 2048 + c), wb = *(const f32x4*)(cw + q * 2048 + c + 4);
      w[q][0] = wa[0]; w[q][1] = wa[1]; w[q][2] = wa[2]; w[q][3] = wa[3]; w[q][4] = wb[0]; w[q][5] = wb[1]; w[q][6] = wb[2]; w[q][7] = wb[3];
    }
    { const f32x4 ba = *(const f32x4*)(cb + c), bb = *(const f32x4*)(cb + c + 4);
      bias[0] = ba[0]; bias[1] = ba[1]; bias[2] = ba[2]; bias[3] = ba[3]; bias[4] = bb[0]; bias[5] = bb[1]; bias[6] = bb[2]; bias[7] = bb[3]; }
    u32x4 x[8];
#pragma unroll
    for (int r = 0; r < 8; ++r) {
      const int t = t0 - 2 + r;
      x[r] = (u32x4){0u, 0u, 0u, 0u};
      if (t >= 0 && t < Ls) x[r] = *(const u32x4*)(QK + (size_t)(r0 - 2 + r) * 2048 + c);
    }
    const float sc = (c < 1024) ? 0.0625f : 1.f;
#pragma unroll
    for (int o = 0; o < 4; ++o) {
      float a[8];
#pragma unroll
      for (int e = 0; e < 8; ++e) a[e] = bias[e];
#pragma unroll
      for (int q = 0; q < 5; ++q)
#pragma unroll
        for (int e = 0; e < 4; ++e) {
          a[2 * e] += w[q][2 * e] * __uint_as_float(x[o + q][e] << 16);
          a[2 * e + 1] += w[q][2 * e + 1] * __uint_as_float(x[o + q][e] & 0xffff0000u);
        }
      u32x4 ov;
#pragma unroll
      for (int e = 0; e < 4; ++e) ov[e] = pack2(silu_f(a[2 * e]) * sc, silu_f(a[2 * e + 1]) * sc);
      *(u32x4*)(QKC + (size_t)(r0 + o) * 2048 + c) = ov;
    }
  }
}

__device__ __forceinline__ void mlstm_scan(const P& p_unused, int j, char* smem, int bid) {
  const P& p = params();
  const int tid = ltid(), lane = tid & 63, wv = tid >> 6, fr = lane & 15, fq = lane >> 4;
  const int dir = bid >> 7, head = (bid >> 5) & 3, sl = bid & 31;
  bf16_t* sQb = (bf16_t*)smem;
  bf16_t* sKb = sQb + 32 * 264;
  bf16_t* sKT = sKb + 32 * 264;
  bf16_t* sVT = sKT + 256 * 40;
  bf16_t* sCb = sVT + 16 * 40;
  float* sI = (float*)(sCb + 16 * 264);
  float* sN = sI + 512;
  float* sCS = sN + 512;
  float* sLU = sCS + 32;
  float* sEM = sLU + 32;
  f32x4* sGt = (f32x4*)(sEM + 32);
  const bf16_t* QKC = (const bf16_t*)(p.ws + OFF_R);
  const bf16_t* V = (const bf16_t*)(p.ws + OFF_U) + 3 * E_ELEMS;
  const f32x4* gates = (const f32x4*)(p.ws + OFF_BONUS) + (size_t)(dir * 4 + head) * MT;
  bf16_t* hdir = (bf16_t*)(p.ws + OFF_U) + E_ELEMS + (size_t)dir * E_ELEMS;
  for (int e = tid; e < 16 * 40; e += 256) sVT[e] = 0;
  u32x4 preA[8], preB[8]; u32x4 prevA = {0u, 0u, 0u, 0u}, prevB = {0u, 0u, 0u, 0u}; f32x4 pregA = {0.f, 0.f, 0.f, 0.f}, pregB = {0.f, 0.f, 0.f, 0.f};
#define ML_ISSUE(CI, pre, prev, preg)                                                                                     \
  {                                                                                                      \
    int rb_, t0_, Ls_; chunk_pos((CI), dir, rb_, t0_, Ls_); (void)Ls_;                                   \
    _Pragma("unroll") for (int i = 0; i < 8; ++i) {                                                      \
      const int idx = tid + 256 * i, tt = idx >> 6, v = idx & 63;                                        \
      const int gc = (v < 32) ? head * 256 + v * 8 : 1024 + head * 256 + (v - 32) * 8;                   \
      pre[i] = *(const u32x4*)(QKC + (size_t)(rb_ + t0_ + tt) * 2048 + gc);                              \
    }                                                                                                    \
    if (tid < 32) {                                                                                      \
      prev = *(const u32x4*)(V + (size_t)(rb_ + t0_ + tid) * 1024 + head * 256 + sl * 8);                \
      preg = gates[rb_ + t0_ + tid];                                                                     \
    }                                                                                                    \
  }
#define ML_COMMIT(pre, prev, preg)                                                                                      \
  {                                                                                                      \
    _Pragma("unroll") for (int i = 0; i < 8; ++i) {                                                      \
      const int idx = tid + 256 * i, tt = idx >> 6, v = idx & 63;                                        \
      const int lr = dir ? 31 - tt : tt;                                                                 \
      if (v < 32) *(u32x4*)(sQb + lr * 264 + v * 8) = pre[i];                                            \
      else *(u32x4*)(sKb + lr * 264 + (v - 32) * 8) = pre[i];                                            \
    }                                                                                                    \
    if (tid < 32) {                                                                                      \
      const int lr = dir ? 31 - tid : tid;                                                               \
      sGt[lr] = preg;                                                                                    \
      _Pragma("unroll") for (int e = 0; e < 4; ++e) {                                                    \
        sVT[(2 * e) * 40 + lr] = (bf16_t)(prev[e] & 0xffffu); sVT[(2 * e + 1) * 40 + lr] = (bf16_t)(prev[e] >> 16); } \
      sVT[8 * 40 + lr] = (bf16_t)0x3F80;                                                                 \
    }                                                                                                    \
  }
  __syncthreads();
  ML_ISSUE(0, preA, prevA, pregA);
  ML_ISSUE(1, preB, prevB, pregB);
  ML_COMMIT(preA, prevA, pregA);
  LDS_BARRIER();
  f32x4 acc[4];
#pragma unroll
  for (int i = 0; i < 4; ++i) acc[i] = (f32x4){0.f, 0.f, 0.f, 0.f};
  for (int c2 = 0; c2 < 520; c2 += 2) {
#pragma unroll
    for (int half = 0; half < 2; ++half) {
    const int ci = c2 + half;
    int rbase, t0, Ls; chunk_pos(ci, dir, rbase, t0, Ls); (void)Ls;
    if (half == 0) { if (ci + 2 < 520) ML_ISSUE(ci + 2, preA, prevA, pregA); }
    else { if (ci + 2 < 520) ML_ISSUE(ci + 2, preB, prevB, pregB); }
    if (wv == 0) {
      const int l5 = lane & 31;
      const f32x4 g = sGt[l5];
      float x = g[0];
#pragma unroll
      for (int off = 1; off < 32; off <<= 1) { const float y = __shfl_up(x, off); if (l5 >= off) x += y; }
      if (lane < 32) { sCS[lane] = x; sLU[lane] = g[1] - x; sEM[lane] = g[2]; }
    }
#pragma unroll
    for (int i = 0; i < 4; ++i)
#pragma unroll
      for (int jj = 0; jj < 4; ++jj) sCb[(fq * 4 + jj) * 264 + (wv * 4 + i) * 16 + fr] = f2bf(acc[i][jj]);
    LDS_BARRIER();
    if (wv < 2) {
      const int st = wv;
      f32x4 sa[2];
      sa[0] = (f32x4){0.f, 0.f, 0.f, 0.f}; sa[1] = sa[0];
#pragma unroll
      for (int ks = 0; ks < 8; ++ks) {
        const bf16x8 qf = *(const bf16x8*)(sQb + (st * 16 + fr) * 264 + ks * 32 + fq * 8);
#pragma unroll
        for (int ut = 0; ut < 2; ++ut) {
          const bf16x8 kf = *(const bf16x8*)(sKb + (ut * 16 + fr) * 264 + ks * 32 + fq * 8);
          sa[ut] = __builtin_amdgcn_mfma_f32_16x16x32_bf16(kf, qf, sa[ut], 0, 0, 0);
        }
      }
      const int s = st * 16 + fr;
      const float css = sCS[s];
      float e[8];
#pragma unroll
      for (int ut = 0; ut < 2; ++ut)
#pragma unroll
        for (int jj = 0; jj < 4; ++jj) {
          const int u = ut * 16 + fq * 4 + jj;
          e[ut * 4 + jj] = (u <= s) ? sa[ut][jj] * __expf(css + sLU[u]) : 0.f;
        }
      u32x4 pk; pk[0] = pack2(e[0], e[1]); pk[1] = pack2(e[2], e[3]); pk[2] = pack2(e[4], e[5]); pk[3] = pack2(e[6], e[7]);
      const u32x2 v0 = *(const u32x2*)(sVT + fr * 40 + fq * 4), v1 = *(const u32x2*)(sVT + fr * 40 + 16 + fq * 4);
      u32x4 vv; vv[0] = v0[0]; vv[1] = v0[1]; vv[2] = v1[0]; vv[3] = v1[1];
      f32x4 o = {0.f, 0.f, 0.f, 0.f};
      o = __builtin_amdgcn_mfma_f32_16x16x32_bf16(__builtin_bit_cast(bf16x8, vv), __builtin_bit_cast(bf16x8, pk), o, 0, 0, 0);
#pragma unroll
      for (int jj = 0; jj < 4; ++jj) sN[(fq * 4 + jj) * 32 + s] = o[jj];
    } else {
      const int st = wv - 2;
      f32x4 ia = {0.f, 0.f, 0.f, 0.f};
#pragma unroll
      for (int ks = 0; ks < 8; ++ks) {
        const bf16x8 cf = *(const bf16x8*)(sCb + fr * 264 + ks * 32 + fq * 8);
        const bf16x8 qf = *(const bf16x8*)(sQb + (st * 16 + fr) * 264 + ks * 32 + fq * 8);
        ia = __builtin_amdgcn_mfma_f32_16x16x32_bf16(cf, qf, ia, 0, 0, 0);
      }
      const int s = st * 16 + fr;
      const float wg = __expf(sCS[s]);
#pragma unroll
      for (int jj = 0; jj < 4; ++jj) sI[(fq * 4 + jj) * 32 + s] = ia[jj] * wg;
    }
    LDS_BARRIER();
    {
      const int s = tid >> 3, v = tid & 7;
      const float num = sN[v * 32 + s] + sI[v * 32 + s];
      const float den = sN[8 * 32 + s] + sI[8 * 32 + s];
      const float h = num * __builtin_amdgcn_rcpf(fmaxf(fabsf(den), sEM[s]));
      const int tt = dir ? 31 - s : s;
      hdir[(size_t)(rbase + t0 + tt) * 1024 + head * 256 + sl * 8 + v] = f2bf(h);
    }
    {
      const float cs31 = sCS[31];
      const float keep = __expf(cs31);
      const u32x4 vr = *(const u32x4*)(sVT + fr * 40 + fq * 8);
      const f32x4 lu0 = *(const f32x4*)(sLU + fq * 8), lu1 = *(const f32x4*)(sLU + fq * 8 + 4);
      u32x4 aw;
      aw[0] = pack2(__uint_as_float(vr[0] << 16) * __expf(cs31 + lu0[0]), __uint_as_float(vr[0] & 0xffff0000u) * __expf(cs31 + lu0[1]));
      aw[1] = pack2(__uint_as_float(vr[1] << 16) * __expf(cs31 + lu0[2]), __uint_as_float(vr[1] & 0xffff0000u) * __expf(cs31 + lu0[3]));
      aw[2] = pack2(__uint_as_float(vr[2] << 16) * __expf(cs31 + lu1[0]), __uint_as_float(vr[2] & 0xffff0000u) * __expf(cs31 + lu1[1]));
      aw[3] = pack2(__uint_as_float(vr[3] << 16) * __expf(cs31 + lu1[2]), __uint_as_float(vr[3] & 0xffff0000u) * __expf(cs31 + lu1[3]));
      const bf16x8 af = __builtin_bit_cast(bf16x8, aw);
#pragma unroll
      for (int i = 0; i < 4; ++i) {
        const bf16_t* kc = sKb + (fq * 8) * 264 + (wv * 4 + i) * 16 + fr;
        u32x4 kw;
        kw[0] = (unsigned)kc[0] | ((unsigned)kc[264] << 16); kw[1] = (unsigned)kc[2 * 264] | ((unsigned)kc[3 * 264] << 16);
        kw[2] = (unsigned)kc[4 * 264] | ((unsigned)kc[5 * 264] << 16); kw[3] = (unsigned)kc[6 * 264] | ((unsigned)kc[7 * 264] << 16);
        acc[i] = __builtin_amdgcn_mfma_f32_16x16x32_bf16(af, __builtin_bit_cast(bf16x8, kw), acc[i] * keep, 0, 0, 0);
      }
    }
    LDS_BARRIER();
    if (half == 0) { ML_COMMIT(preB, prevB, pregB); }
    else { if (ci + 1 < 520) ML_COMMIT(preA, prevA, pregA); }
    LDS_BARRIER();
    }
  }
#undef ML_ISSUE
#undef ML_COMMIT
}

__device__ __forceinline__ void mlstm_post(const P& p_unused, int j) {
  const P& p = params();
  const int tid_ = ltid(); const int lane = tid_ & 63, wv = tid_ >> 6;
  bf16_t* Z = (bf16_t*)(p.ws + OFF_U);
  const bf16_t* O = (const bf16_t*)(p.ws + OFF_U) + 4 * E_ELEMS;
  const bf16_t* hf = (const bf16_t*)(p.ws + OFF_U) + E_ELEMS;
  const bf16_t* hb = hf + E_ELEMS;
  const int c0 = lane * 16;
  float nw[16];
#pragma unroll
  for (int i = 0; i < 16; ++i) nw[i] = p.ml_norm_w[j * 1024 + c0 + i];
  for (int row = lbid() * 4 + wv; row < MT; row += gridDim.x * 4) {
    const size_t off = (size_t)row * 1024 + c0;
    float a[16], b2[16], o[16], z[16];
    unpack8(*(const u32x4*)(hf + off), a); unpack8(*(const u32x4*)(hf + off + 8), a + 8);
    unpack8(*(const u32x4*)(hb + off), b2); unpack8(*(const u32x4*)(hb + off + 8), b2 + 8);
    unpack8(*(const u32x4*)(O + off), o); unpack8(*(const u32x4*)(O + off + 8), o + 8);
    unpack8(*(const u32x4*)(Z + off), z); unpack8(*(const u32x4*)(Z + off + 8), z + 8);
    float ss = 0.f;
#pragma unroll
    for (int i = 0; i < 16; ++i) { a[i] += b2[i]; ss += a[i] * a[i]; }
    ss = sum16(ss);
    const float rs = rsqrtf(ss * (1.f / 256.f) + 1e-6f);
    float r[16];
#pragma unroll
    for (int i = 0; i < 16; ++i) r[i] = a[i] * rs * nw[i] * sigmoid_f(o[i]) * silu_f(z[i]);
    u32x4 w0, w1;
    w0[0] = pack2(r[0], r[1]); w0[1] = pack2(r[2], r[3]); w0[2] = pack2(r[4], r[5]); w0[3] = pack2(r[6], r[7]);
    w1[0] = pack2(r[8], r[9]); w1[1] = pack2(r[10], r[11]); w1[2] = pack2(r[12], r[13]); w1[3] = pack2(r[14], r[15]);
    *(u32x4*)(Z + off) = w0; *(u32x4*)(Z + off + 8) = w1;
  }
}

__device__ __forceinline__ void attn_prep(const P& p_unused, int j, char* smem) {
  const P& p = params();
  const int tid = ltid();
  bf16_t* Q = (bf16_t*)(p.ws + OFF_U) + 2 * E_ELEMS;
  bf16_t* KV = (bf16_t*)(p.ws + OFF_U) + 3 * E_ELEMS;
  bf16_t* VT = KV + E_ELEMS / 2;
  const float* qn = p.at_q_norm + j * 64;
  const float* kn = p.at_k_norm + j * 64;
  const int total = MT * 20;
  for (int idx = lbid() * 256 + tid; idx < total; idx += gridDim.x * 256) {
    const int t = idx / 20, u = idx - t * 20;
    bf16_t* ptr; const float* w; float scale;
    if (u < 16) { ptr = Q + (size_t)t * 1024 + u * 64; w = qn; scale = 0.125f * 1.4426950408889634f; }
    else { ptr = KV + (size_t)t * 512 + (u - 16) * 64; w = kn; scale = 1.f; }
    float x[64]; float ss = 0.f;
#pragma unroll
    for (int i = 0; i < 8; ++i) {
      const u32x4 v = *(const u32x4*)(ptr + i * 8);
#pragma unroll
      for (int e = 0; e < 4; ++e) {
        x[i * 8 + 2 * e] = __uint_as_float(v[e] << 16);
        x[i * 8 + 2 * e + 1] = __uint_as_float(v[e] & 0xffff0000u);
      }
    }
#pragma unroll
    for (int i = 0; i < 64; ++i) ss += x[i] * x[i];
    const float rs = rsqrtf(ss * (1.f / 64.f) + 1e-6f);
#pragma unroll
    for (int i = 0; i < 64; ++i) x[i] = x[i] * rs * w[i];
    if (t < TL) {
      const float rowi = (float)(t >> 6), coli = (float)(t & 63);
#pragma unroll
      for (int i = 0; i < 16; ++i) {
        const float inv = exp2f(-(float)i * (13.287712379549449f / 16.f));
        float tr = rowi * inv * 0.15915494309189535f; tr -= floorf(tr);
        float tc = coli * inv * 0.15915494309189535f; tc -= floorf(tc);
        const float cr = __builtin_amdgcn_cosf(tr), sr = __builtin_amdgcn_sinf(tr);
        const float cc = __builtin_amdgcn_cosf(tc), sc = __builtin_amdgcn_sinf(tc);
        const float a1 = x[i], a2 = x[i + 16];
        x[i] = a1 * cr - a2 * sr; x[i + 16] = a1 * sr + a2 * cr;
        const float b1 = x[32 + i], b2 = x[48 + i];
        x[32 + i] = b1 * cc - b2 * sc; x[48 + i] = b1 * sc + b2 * cc;
      }
    }
#pragma unroll
    for (int i = 0; i < 8; ++i) {
      u32x4 v;
#pragma unroll
      for (int e = 0; e < 4; ++e) v[e] = pack2(x[i * 8 + 2 * e] * scale, x[i * 8 + 2 * e + 1] * scale);
      *(u32x4*)(ptr + i * 8) = v;
    }
  }
  bf16_t* sT = (bf16_t*)smem;
  for (int it = lbid(); it < 260 * 4; it += gridDim.x) {
    const int tb = (it >> 2) * 64, cbk = (it & 3) * 64;
    {
      const int tt = tid >> 2, cq = (tid & 3) * 16;
      const bf16_t* s = KV + (size_t)(tb + tt) * 512 + 256 + cbk + cq;
      const u32x4 v0 = *(const u32x4*)s, v1 = *(const u32x4*)(s + 8);
#pragma unroll
      for (int e = 0; e < 4; ++e) {
        sT[(cq + 2 * e) * 72 + tt] = (bf16_t)(v0[e] & 0xffffu); sT[(cq + 2 * e + 1) * 72 + tt] = (bf16_t)(v0[e] >> 16);
        sT[(cq + 8 + 2 * e) * 72 + tt] = (bf16_t)(v1[e] & 0xffffu); sT[(cq + 8 + 2 * e + 1) * 72 + tt] = (bf16_t)(v1[e] >> 16);
      }
    }
    __syncthreads();
    {
      const int c = tid >> 2, tq = (tid & 3) * 16;
      const u32x4 v0 = *(const u32x4*)(sT + c * 72 + tq), v1 = *(const u32x4*)(sT + c * 72 + tq + 8);
      bf16_t* d = VT + (size_t)(cbk + c) * MT + tb + tq;
      *(u32x4*)d = v0; *(u32x4*)(d + 8) = v1;
    }
    __syncthreads();
  }
}

__device__ __forceinline__ void attn_phase(const P& p_unused, int j, char* smem) {
  const P& p = params();
  const int tid = ltid(), lane = tid & 63, wv = tid >> 6, fr = lane & 15, fq = lane >> 4;
  bf16_t* G = (bf16_t*)(p.ws + OFF_U) + E_ELEMS;
  const bf16_t* Q = (const bf16_t*)(p.ws + OFF_U) + 2 * E_ELEMS;
  const bf16_t* KV = (const bf16_t*)(p.ws + OFF_U) + 3 * E_ELEMS;
  const bf16_t* VT = KV + E_ELEMS / 2;
  bf16_t* sK = (bf16_t*)smem;
  bf16_t* sV = sK + 2 * 64 * 72;
  float gq = 0.f, gk = 0.f;
  for (int i = 0; i < 64; ++i) { gq = fmaxf(gq, fabsf(p.at_q_norm[j * 64 + i])); gk = fmaxf(gk, fabsf(p.at_k_norm[j * 64 + i])); }
  const float nshift = -(8.f * gq * gk * 1.4426950408889634f);
  for (int item = lbid(); item < 1024 + 16; item += gridDim.x) {
    int head, q0, kv0, nkt;
    if (item < 1024) { head = item & 15; q0 = (item >> 4) * 256; kv0 = 0; nkt = 260; }
    else { head = item - 1024; q0 = TL; kv0 = TL; nkt = 4; }
    const int kvh = head >> 2;
    bf16x8 qf[4][2];
#pragma unroll
    for (int qt = 0; qt < 4; ++qt)
#pragma unroll
      for (int ks = 0; ks < 2; ++ks)
        qf[qt][ks] = *(const bf16x8*)(Q + (size_t)(q0 + wv * 64 + qt * 16 + fr) * 1024 + head * 64 + ks * 32 + fq * 8);
    f32x4 o[4][4]; float ls[4];
#pragma unroll
    for (int a = 0; a < 4; ++a) { ls[a] = 0.f;
#pragma unroll
      for (int b = 0; b < 4; ++b) o[a][b] = (f32x4){0.f, 0.f, 0.f, 0.f}; }
    u32x4 rk[2], rv[2];
#pragma unroll
    for (int i = 0; i < 2; ++i) {
      const int id = tid + 256 * i, r = id >> 3, ch = (id & 7) * 8;
      rk[i] = *(const u32x4*)(KV + (size_t)(kv0 + r) * 512 + kvh * 64 + ch);
      rv[i] = *(const u32x4*)(VT + (size_t)(kvh * 64 + r) * MT + kv0 + ch);
    }
#pragma unroll
    for (int i = 0; i < 2; ++i) {
      const int id = tid + 256 * i, r = id >> 3, ch = (id & 7) * 8;
      *(u32x4*)(sK + r * 72 + ch) = rk[i];
      *(u32x4*)(sV + r * 72 + ch) = rv[i];
    }
    __syncthreads();
    for (int kt = 0; kt < nkt; ++kt) {
      const bf16_t* bK = sK + (kt & 1) * 64 * 72;
      const bf16_t* bV = sV + (kt & 1) * 64 * 72;
      if (kt + 1 < nkt) {
#pragma unroll
        for (int i = 0; i < 2; ++i) {
          const int id = tid + 256 * i, r = id >> 3, ch = (id & 7) * 8;
          rk[i] = *(const u32x4*)(KV + (size_t)(kv0 + (kt + 1) * 64 + r) * 512 + kvh * 64 + ch);
          rv[i] = *(const u32x4*)(VT + (size_t)(kvh * 64 + r) * MT + kv0 + (kt + 1) * 64 + ch);
        }
      }
#pragma unroll 1
      for (int kk = 0; kk < 2; ++kk) {
        f32x4 s[2][4];
#pragma unroll
        for (int a = 0; a < 2; ++a)
#pragma unroll
          for (int b = 0; b < 4; ++b) s[a][b] = (f32x4){nshift, nshift, nshift, nshift};
#pragma unroll
        for (int a = 0; a < 2; ++a)
#pragma unroll
          for (int ks = 0; ks < 2; ++ks) {
            const bf16x8 kf = *(const bf16x8*)(bK + ((kk * 2 + a) * 16 + fr) * 72 + ks * 32 + fq * 8);
#pragma unroll
            for (int qt = 0; qt < 4; ++qt) s[a][qt] = __builtin_amdgcn_mfma_f32_16x16x32_bf16(kf, qf[qt][ks], s[a][qt], 0, 0, 0);
          }
        bf16x8 pb[4];
#pragma unroll
        for (int qt = 0; qt < 4; ++qt) {
          float e[8];
#pragma unroll
          for (int i = 0; i < 4; ++i) { e[i] = __builtin_amdgcn_exp2f(s[0][qt][i]); e[4 + i] = __builtin_amdgcn_exp2f(s[1][qt][i]); }
          ls[qt] += ((e[0] + e[1]) + (e[2] + e[3])) + ((e[4] + e[5]) + (e[6] + e[7]));
          u32x4 pk; pk[0] = pack2(e[0], e[1]); pk[1] = pack2(e[2], e[3]); pk[2] = pack2(e[4], e[5]); pk[3] = pack2(e[6], e[7]);
          pb[qt] = __builtin_bit_cast(bf16x8, pk);
        }
#pragma unroll
        for (int dt = 0; dt < 4; ++dt) {
          const u32x2 v0 = *(const u32x2*)(bV + (dt * 16 + fr) * 72 + kk * 32 + fq * 4);
          const u32x2 v1 = *(const u32x2*)(bV + (dt * 16 + fr) * 72 + kk * 32 + 16 + fq * 4);
          u32x4 vv; vv[0] = v0[0]; vv[1] = v0[1]; vv[2] = v1[0]; vv[3] = v1[1];
          const bf16x8 vf = __builtin_bit_cast(bf16x8, vv);
#pragma unroll
          for (int qt = 0; qt < 4; ++qt) o[dt][qt] = __builtin_amdgcn_mfma_f32_16x16x32_bf16(vf, pb[qt], o[dt][qt], 0, 0, 0);
        }
      }
      if (kt + 1 < nkt) {
        bf16_t* nK = sK + ((kt + 1) & 1) * 64 * 72;
        bf16_t* nV = sV + ((kt + 1) & 1) * 64 * 72;
#pragma unroll
        for (int i = 0; i < 2; ++i) {
          const int id = tid + 256 * i, r = id >> 3, ch = (id & 7) * 8;
          *(u32x4*)(nK + r * 72 + ch) = rk[i];
          *(u32x4*)(nV + r * 72 + ch) = rv[i];
        }
      }
      __syncthreads();
    }
#pragma unroll
    for (int qt = 0; qt < 4; ++qt) {
      float l = ls[qt];
      l += __shfl_xor(l, 16); l += __shfl_xor(l, 32);
      const float inv = 1.f / l;
      const int row = q0 + wv * 64 + qt * 16 + fr;
#pragma unroll
      for (int dt = 0; dt < 4; ++dt) {
        bf16_t* gp = G + (size_t)row * 1024 + head * 64 + dt * 16 + fq * 4;
        const u32x2 gv = *(const u32x2*)gp;
        const float g0 = __uint_as_float(gv[0] << 16), g1 = __uint_as_float(gv[0] & 0xffff0000u);
        const float g2 = __uint_as_float(gv[1] << 16), g3 = __uint_as_float(gv[1] & 0xffff0000u);
        u32x2 ov;
        ov[0] = pack2(o[dt][qt][0] * inv * silu_f(g0), o[dt][qt][1] * inv * silu_f(g1));
        ov[1] = pack2(o[dt][qt][2] * inv * silu_f(g2), o[dt][qt][3] * inv * silu_f(g3));
        *(u32x2*)gp = ov;
      }
    }
  }
}

__device__ __forceinline__ void final_norm(const P& p_unused) {
  const P& p = params();
  const int tid_ = ltid(); const int lane = tid_ & 63, wv = tid_ >> 6;
  for (int row = lbid() * 4 + wv; row < TL; row += gridDim.x * 4) {
    float* src = p.out + (size_t)row * 1024;
    f32x4 v[4]; float ss = 0.f;
#pragma unroll
    for (int i = 0; i < 4; ++i) { v[i] = *(const f32x4*)(src + i * 256 + lane * 4); ss += v[i][0] * v[i][0] + v[i][1] * v[i][1] + v[i][2] * v[i][2] + v[i][3] * v[i][3]; }
    ss = wave_sum(ss);
    const float rs = rsqrtf(ss * (1.f / 1024.f) + 1e-6f);
#pragma unroll
    for (int i = 0; i < 4; ++i) {
      const f32x4 g = *(const f32x4*)(p.norm_final + i * 256 + lane * 4);
      f32x4 o; o[0] = v[i][0] * rs * g[0]; o[1] = v[i][1] * rs * g[1]; o[2] = v[i][2] * rs * g[2]; o[3] = v[i][3] * rs * g[3];
      *(f32x4*)(src + i * 256 + lane * 4) = o;
    }
  }
}


__device__ __forceinline__ void grid_barrier(unsigned* bar, unsigned epoch) {
  __syncthreads();
  if (threadIdx.x == 0) {
    __threadfence();
    const unsigned ngroups = gridDim.x >> 5;
    const unsigned g = blockIdx.x >> 5;
    const unsigned old = __hip_atomic_fetch_add(bar + 64 * (2 + g), 1u, __ATOMIC_RELAXED, __HIP_MEMORY_SCOPE_AGENT);
    if (old == 32u * epoch - 1u) {
      const unsigned o2 = __hip_atomic_fetch_add(bar + 64, 1u, __ATOMIC_RELAXED, __HIP_MEMORY_SCOPE_AGENT);
      if (o2 == ngroups * epoch - 1u) __hip_atomic_store(bar, epoch, __ATOMIC_RELAXED, __HIP_MEMORY_SCOPE_AGENT);
    }
    while (__hip_atomic_load(bar, __ATOMIC_RELAXED, __HIP_MEMORY_SCOPE_AGENT) < epoch) __builtin_amdgcn_s_sleep(32);
    __threadfence();
  }
  __syncthreads();
}


__device__ __forceinline__ void ab_prep(const P& p_unused, int j, unsigned* bar, unsigned& epoch) {
  const P& p = params();
  const int tid = ltid(), bid = lbid();
  bf16_t* XBC = (bf16_t*)(p.ws + OFF_U) + (E_ELEMS * 13) / 4;
  bf16_t* URK = (bf16_t*)(p.ws + OFF_U) + E_ELEMS;
  const float* cw = p.mb_conv_w + (size_t)j * 5 * 1536;
  const float* cb = p.mb_conv_b + j * 1536;
  const float* mu = p.rk_mu + j * 1792;
  for (int ubase = 0; ubase < 260; ubase += gridDim.x) {
  const int unit = ubase + bid;
  const bool act = unit < 260;
  const int rbase = (unit < 256) ? 0 : TL, t0 = (unit < 256) ? unit * 64 : (unit - 256) * 64, Ls = (unit < 256) ? TL : TC;
  unsigned hm2[7], hm1[7], hp0[7], hp1[7];
#pragma unroll
  for (int k = 0; k < 7; ++k) {
    hm2[k] = 0u; hm1[k] = 0u; hp0[k] = 0u; hp1[k] = 0u;
    const int pi = tid + 256 * k;
    if (act && pi < 1664) {
      const bf16_t* base = (pi < 768) ? XBC + 2 * pi : URK + 2 * (pi - 768);
      const int ld = (pi < 768) ? 1536 : 2304;
      const bf16_t* r0 = base + (size_t)(rbase + t0) * ld;
      if (t0 - 2 >= 0) hm2[k] = *(const unsigned*)(r0 - 2 * ld);
      if (t0 - 1 >= 0) hm1[k] = *(const unsigned*)(r0 - ld);
      if (t0 + 64 < Ls) hp0[k] = *(const unsigned*)(r0 + 64 * ld);
      if (t0 + 65 < Ls) hp1[k] = *(const unsigned*)(r0 + 65 * ld);
    }
  }
  grid_barrier(bar, ++epoch);
  if (act) {
#pragma unroll
  for (int k = 0; k < 7; ++k) {
    const int pi = tid + 256 * k;
    if (pi >= 1664) continue;
    if (pi < 768) {
      const int c = 2 * pi;
      bf16_t* r0 = XBC + (size_t)(rbase + t0) * 1536 + c;
      float wa[5], wb[5];
#pragma unroll
      for (int q = 0; q < 5; ++q) { wa[q] = cw[q * 1536 + c]; wb[q] = cw[q * 1536 + c + 1]; }
      const float ba = cb[c], bb = cb[c + 1];
      unsigned w0 = hm2[k], w1 = hm1[k], w2 = *(const unsigned*)r0, w3 = *(const unsigned*)(r0 + 1536);
#pragma unroll
      for (int s0 = 0; s0 < 64; s0 += 16) {
        unsigned nx[16];
#pragma unroll
        for (int i = 0; i < 16; ++i) { const int t = s0 + i + 2; nx[i] = (t < 64) ? *(const unsigned*)(r0 + (size_t)t * 1536) : ((t == 64) ? hp0[k] : hp1[k]); }
#pragma unroll
        for (int i = 0; i < 16; ++i) {
          const unsigned w4 = nx[i];
          const float a0 = ba + wa[0] * __uint_as_float(w0 << 16) + wa[1] * __uint_as_float(w1 << 16) + wa[2] * __uint_as_float(w2 << 16) +
                           wa[3] * __uint_as_float(w3 << 16) + wa[4] * __uint_as_float(w4 << 16);
          const float a1 = bb + wb[0] * __uint_as_float(w0 & 0xffff0000u) + wb[1] * __uint_as_float(w1 & 0xffff0000u) + wb[2] * __uint_as_float(w2 & 0xffff0000u) +
                           wb[3] * __uint_as_float(w3 & 0xffff0000u) + wb[4] * __uint_as_float(w4 & 0xffff0000u);
          *(unsigned*)(r0 + (size_t)(s0 + i) * 1536) = pack2(silu_f(a0), silu_f(a1));
          w0 = w1; w1 = w2; w2 = w3; w3 = w4;
        }
      }
    } else {
      const int c = 2 * (pi - 768);
      bf16_t* r0 = URK + (size_t)(rbase + t0) * 2304 + c;
      const float m0 = mu[c], m1 = mu[c + 1];
      const bool is_wl = (c >= 1536) && (c < 1664);
      unsigned prev = hm1[k], cur = *(const unsigned*)r0;
#pragma unroll
      for (int s0 = 0; s0 < 64; s0 += 16) {
        unsigned nx[16];
#pragma unroll
        for (int i = 0; i < 16; ++i) { const int t = s0 + i + 1; nx[i] = (t < 64) ? *(const unsigned*)(r0 + (size_t)t * 2304) : hp0[k]; }
#pragma unroll
        for (int i = 0; i < 16; ++i) {
          const unsigned nxt = nx[i];
          const float c0 = __uint_as_float(cur << 16), c1 = __uint_as_float(cur & 0xffff0000u);
          float v0 = c0 + m0 * (0.5f * (__uint_as_float(prev << 16) + __uint_as_float(nxt << 16)) - c0);
          float v1 = c1 + m1 * (0.5f * (__uint_as_float(prev & 0xffff0000u) + __uint_as_float(nxt & 0xffff0000u)) - c1);
          if (is_wl) {
            const float e0 = __expf(2.f * v0), e1 = __expf(2.f * v1);
            v0 = 1.f - 2.f * __builtin_amdgcn_rcpf(e0 + 1.f); v1 = 1.f - 2.f * __builtin_amdgcn_rcpf(e1 + 1.f);
          }
          *(unsigned*)(r0 + (size_t)(s0 + i) * 2304) = pack2(v0, v1);
          prev = cur; cur = nxt;
        }
      }
    }
  }
  }
  }
}

__global__ void __launch_bounds__(256, 2) mega_fwd(P p) {
  extern __shared__ __attribute__((aligned(16))) char smem[];
  cg::grid_group grid = cg::this_grid();
  mods_phase(p, smem);
  grid.sync();
  unsigned epoch = 0;
    for (int step = 0; step < 40; ++step) {
    const int l = step / 10, idx = step - l * 10, j = l >> 1;
    const unsigned long long ops = (l & 1) ? 0xF198176A10ull : 0xFFFF1CBD10ull;
    const unsigned long long ags = (l & 1) ? 0x0400300020ull : 0x0000400000ull;
    const int op = (int)((ops >> (4 * idx)) & 15), arg = (int)((ags >> (4 * idx)) & 15);
    if (op == 15) continue;
    if (op == 0 || op == 7) { if (op == 7) mlstm_post(p, j); norm_phase(p, l); transposes_for_layer(p, l, (op == 7) ? 1 : arg, smem); }
    else if (op == 1) gemm_phase(p, arg, l, smem);
    else if (op == 6) { for (int b = lbid(); b < 256; b += gridDim.x) { mlstm_scan(p, j, smem, b); __syncthreads(); } }
    else if (op == 8) attn_prep(p, j, smem);
    else if (op == 10) ml_prep(p, j);
    else if (op == 13) ab_prep(p, j, (unsigned*)(params().ws + OFF_BAR), epoch);
    else if (op == 11) { const int b = lbid(); if (b < 128) mamba_scan(p, j, smem, b); else if (b < 192) rwkv_scan(p, j, smem, b - 128); }
    else if (op == 12) { mamba_post(p, j); rwkv_post(p, j); }
    else attn_phase(p, j, smem);
    grid_barrier((unsigned*)(params().ws + OFF_BAR), ++epoch);
  }
  final_norm(p);
}

extern "C" void kernel_launch(void* const* d_in, const int* in_sizes, int n_in, void* d_out, int out_size, void* d_ws, size_t ws_size,
                              hipStream_t stream) {
  static int grid_blocks = 0;
  if (!grid_blocks) {
    int dev = 0, cus = 0, per_cu = 0;
    (void)hipGetDevice(&dev);
    (void)hipDeviceGetAttribute(&cus, hipDeviceAttributeMultiprocessorCount, dev);
    (void)hipFuncSetAttribute((const void*)mega_fwd, hipFuncAttributeMaxDynamicSharedMemorySize, LDS_BYTES);
    (void)hipOccupancyMaxActiveBlocksPerMultiprocessor(&per_cu, mega_fwd, 256, LDS_BYTES);
    if (per_cu > 2) per_cu = 2;
    if (per_cu < 1) per_cu = 1;
    grid_blocks = cus * per_cu;
  }
  P p{};
  const float** pf = (const float**)&p;
  for (int i = 0; i < 35; ++i) pf[i] = (const float*)d_in[i];
  p.out = (float*)d_out;
  p.ws = (unsigned char*)d_ws;
  (void)hipMemsetAsync((unsigned char*)d_ws + OFF_BAR, 0, 64 * 4 * 32, stream);
  void* args[] = {&p};
  hipError_t e = hipLaunchCooperativeKernel((void*)mega_fwd, dim3(grid_blocks), dim3(256), args, LDS_BYTES, stream);
  if (e != hipSuccess) fprintf(stderr, "cooperative launch failed: %s (grid %d)\n", hipGetErrorString(e), grid_blocks);
}
```
